# Optimizing an MI355X kernel written in HIP

```python
import jax, jax.numpy as jnp
from jax import lax
import numpy as np

D_MODEL = 1024
BATCH = 4
SEQ = 4096
DEPTH = 1

CHUNK = 64
LRU_WIDTH = 512
LRU_HEADS = 8
LRU_HEAD_DIM = LRU_WIDTH // LRU_HEADS
LRU_CONV_WIDTH = 4
LRU_C = 8.0
GMLP_WIDTH = 512
GMLP_GROUPS = 4
GMLP_GROUP_DIM = GMLP_WIDTH // GMLP_GROUPS
GMLP_BLOCK = 128
MIX_WIDTH = LRU_WIDTH + GMLP_WIDTH
IN_COLS = 2 * LRU_WIDTH + 2 * GMLP_WIDTH
D_FF = 3 * D_MODEL
FFN_CONV_WIDTH = 3
N_MOD = 6
EPS = 1e-6

kernel_name = "hybrid_rglru_gmlp_convffn_block"


def rmsnorm(x, g):
    xf = x.astype(jnp.float32)
    y = xf * lax.rsqrt(jnp.mean(xf * xf, axis=-1, keepdims=True) + EPS)
    return (y * g.astype(jnp.float32)).astype(x.dtype)


def layernorm(x, g, b):
    xf = x.astype(jnp.float32)
    mu = jnp.mean(xf, axis=-1, keepdims=True)
    var = jnp.mean(jnp.square(xf - mu), axis=-1, keepdims=True)
    y = (xf - mu) * lax.rsqrt(var + EPS)
    return (y * g.astype(jnp.float32) + b.astype(jnp.float32)).astype(x.dtype)


def causal_depthwise_conv(x, w, b):
    k_width = w.shape[0]
    s = x.shape[1]
    xp = jnp.pad(x, ((0, 0), (k_width - 1, 0), (0, 0)))
    out = xp[:, 0:s] * w[0]
    for k in range(1, k_width):
        out = out + xp[:, k:k + s] * w[k]
    return out + b


def _lin_rec_combine(left, right):
    a1, b1 = left
    a2, b2 = right
    return a1 * a2, a2 * b1 + b2


def rg_lru_group(x_raw, gate_raw, conv_w, conv_b, w_rgate, b_rgate, w_igate, b_igate, lru_a):
    bsz, s, _ = x_raw.shape
    xc = causal_depthwise_conv(x_raw, conv_w, conv_b)
    xh = xc.reshape(bsz, s, LRU_HEADS, LRU_HEAD_DIM)
    r = jax.nn.sigmoid(jnp.einsum('bshi,hij->bshj', xh, w_rgate) + b_rgate).reshape(bsz, s, LRU_WIDTH)
    i = jax.nn.sigmoid(jnp.einsum('bshi,hij->bshj', xh, w_igate) + b_igate).reshape(bsz, s, LRU_WIDTH)
    log_a = -LRU_C * r.astype(jnp.float32) * jax.nn.softplus(-lru_a.astype(jnp.float32))
    a = jnp.exp(log_a)
    mult = jnp.sqrt(-jnp.expm1(2.0 * log_a))
    bx = mult * (i * xc).astype(jnp.float32)
    _, h = lax.associative_scan(_lin_rec_combine, (a, bx), axis=1)
    return h.astype(x_raw.dtype) * jax.nn.gelu(gate_raw)


def gmlp_group(u_raw, v_raw, v_norm_g, v_norm_b, w_spatial, b_spatial):
    bsz, s, _ = u_raw.shape
    u = jax.nn.gelu(u_raw)
    v = layernorm(jax.nn.gelu(v_raw), v_norm_g, v_norm_b)
    vb = v.reshape(bsz, s // GMLP_BLOCK, GMLP_BLOCK, GMLP_GROUPS, GMLP_GROUP_DIM)
    pos = jnp.arange(GMLP_BLOCK)
    mask = (pos[None, :] // CHUNK) <= (pos[:, None] // CHUNK)
    ws = jnp.where(mask[None], w_spatial, jnp.zeros_like(w_spatial))
    sp = jnp.einsum('gij,bnjgc->bnigc', ws, vb) + b_spatial.T[None, None, :, :, None]
    return u * sp.reshape(bsz, s, GMLP_WIDTH)


def setup_inputs(seed: int = 0) -> dict:
    key = jax.random.key(seed)
    ks = jax.random.split(key, 32)
    L = DEPTH

    def nrm(k, shape, scale):
        return jax.random.normal(k, shape, jnp.float32) * scale

    x = nrm(ks[0], (BATCH, SEQ, D_MODEL), 1.0)
    c = nrm(ks[1], (BATCH, D_MODEL), 1.0)
    w_ada = nrm(ks[2], (L, D_MODEL, N_MOD * D_MODEL), 0.5 * D_MODEL ** -0.5)
    b_ada = nrm(ks[3], (L, N_MOD * D_MODEL), 0.02)
    g_mix_pre = 1.0 + nrm(ks[4], (L, D_MODEL), 0.02)
    g_mix_post = 1.0 + nrm(ks[5], (L, D_MODEL), 0.02)
    w_in = nrm(ks[6], (L, D_MODEL, IN_COLS), D_MODEL ** -0.5)
    conv_w = nrm(ks[7], (L, LRU_CONV_WIDTH, LRU_WIDTH), LRU_CONV_WIDTH ** -0.5)
    conv_b = nrm(ks[8], (L, LRU_WIDTH), 0.02)
    w_rgate = nrm(ks[9], (L, LRU_HEADS, LRU_HEAD_DIM, LRU_HEAD_DIM), LRU_HEAD_DIM ** -0.5)
    b_rgate = nrm(ks[10], (L, LRU_HEADS, LRU_HEAD_DIM), 0.02)
    w_igate = nrm(ks[11], (L, LRU_HEADS, LRU_HEAD_DIM, LRU_HEAD_DIM), LRU_HEAD_DIM ** -0.5)
    b_igate = nrm(ks[12], (L, LRU_HEADS, LRU_HEAD_DIM), 0.02)
    a_c = jax.random.uniform(ks[13], (L, LRU_WIDTH), jnp.float32, 0.9, 0.999)
    p = a_c ** (1.0 / LRU_C)
    lru_a = jnp.log(p) - jnp.log1p(-p)
    v_norm_g = 1.0 + nrm(ks[14], (L, GMLP_WIDTH), 0.02)
    v_norm_b = nrm(ks[15], (L, GMLP_WIDTH), 0.02)
    w_spatial = nrm(ks[16], (L, GMLP_GROUPS, GMLP_BLOCK, GMLP_BLOCK), GMLP_BLOCK ** -0.5)
    b_spatial = 1.0 + nrm(ks[17], (L, GMLP_GROUPS, GMLP_BLOCK), 0.02)
    g_lru_out = 1.0 + nrm(ks[18], (L, LRU_WIDTH), 0.02)
    g_gmlp_out = 1.0 + nrm(ks[19], (L, GMLP_WIDTH), 0.02)
    w_out = nrm(ks[20], (L, MIX_WIDTH, D_MODEL), MIX_WIDTH ** -0.5)
    g_ffn_pre = 1.0 + nrm(ks[21], (L, D_MODEL), 0.02)
    g_ffn_post = 1.0 + nrm(ks[22], (L, D_MODEL), 0.02)
    w_up = nrm(ks[23], (L, D_MODEL, 2 * D_FF), D_MODEL ** -0.5)
    ffn_conv_w = nrm(ks[24], (L, FFN_CONV_WIDTH, 2 * D_FF), FFN_CONV_WIDTH ** -0.5)
    ffn_conv_b = nrm(ks[25], (L, 2 * D_FF), 0.02)
    w_down = nrm(ks[26], (L, D_FF, D_MODEL), D_FF ** -0.5)
    return {"x": x, "c": c, "w_ada": w_ada, "b_ada": b_ada,
            "g_mix_pre": g_mix_pre, "g_mix_post": g_mix_post, "w_in": w_in,
            "conv_w": conv_w, "conv_b": conv_b, "w_rgate": w_rgate, "b_rgate": b_rgate,
            "w_igate": w_igate, "b_igate": b_igate, "lru_a": lru_a,
            "v_norm_g": v_norm_g, "v_norm_b": v_norm_b, "w_spatial": w_spatial, "b_spatial": b_spatial,
            "g_lru_out": g_lru_out, "g_gmlp_out": g_gmlp_out, "w_out": w_out,
            "g_ffn_pre": g_ffn_pre, "g_ffn_post": g_ffn_post, "w_up": w_up,
            "ffn_conv_w": ffn_conv_w, "ffn_conv_b": ffn_conv_b, "w_down": w_down}


def reference(x, c, w_ada, b_ada, g_mix_pre, g_mix_post, w_in, conv_w, conv_b,
              w_rgate, b_rgate, w_igate, b_igate, lru_a, v_norm_g, v_norm_b,
              w_spatial, b_spatial, g_lru_out, g_gmlp_out, w_out,
              g_ffn_pre, g_ffn_post, w_up, ffn_conv_w, ffn_conv_b, w_down):
    c_act = jax.nn.silu(c)
    for l in range(DEPTH):
        mod = c_act @ w_ada[l] + b_ada[l]
        sh_m, sc_m, gt_m, sh_f, sc_f, gt_f = [m[:, None, :] for m in jnp.split(mod, N_MOD, axis=-1)]

        h = rmsnorm(x, g_mix_pre[l]) * (1.0 + sc_m) + sh_m
        z = h @ w_in[l]
        lru_x, lru_gate, g_u, g_v = jnp.split(
            z, [LRU_WIDTH, 2 * LRU_WIDTH, 2 * LRU_WIDTH + GMLP_WIDTH], axis=-1)
        y_lru = rg_lru_group(lru_x, lru_gate, conv_w[l], conv_b[l], w_rgate[l], b_rgate[l],
                             w_igate[l], b_igate[l], lru_a[l])
        y_gmlp = gmlp_group(g_u, g_v, v_norm_g[l], v_norm_b[l], w_spatial[l], b_spatial[l])
        y = jnp.concatenate([rmsnorm(y_lru, g_lru_out[l]), rmsnorm(y_gmlp, g_gmlp_out[l])], axis=-1)
        y = y @ w_out[l]
        x = x + gt_m * rmsnorm(y, g_mix_post[l])

        h = rmsnorm(x, g_ffn_pre[l]) * (1.0 + sc_f) + sh_f
        up = causal_depthwise_conv(h @ w_up[l], ffn_conv_w[l], ffn_conv_b[l])
        g_ff, v_ff = jnp.split(up, 2, axis=-1)
        y = (jax.nn.gelu(g_ff) * v_ff) @ w_down[l]
        x = x + gt_f * rmsnorm(y, g_ffn_post[l])
    return x
```

```cpp
#include <hip/hip_runtime.h>
#include <hip/hip_cooperative_groups.h>
#include <cstdio>
#include <cstdint>
namespace cg = cooperative_groups;

#define LAS __attribute__((address_space(3)))
typedef unsigned short bf16_t;
typedef short bf16x8 __attribute__((ext_vector_type(8)));
typedef float f32x4 __attribute__((ext_vector_type(4)));
typedef float f32x2 __attribute__((ext_vector_type(2)));
typedef unsigned u32x4 __attribute__((ext_vector_type(4)));
typedef unsigned u32x2 __attribute__((ext_vector_type(2)));

constexpr int DM = 1024, SEQ = 4096, MTOK = 16384;
constexpr int INC = 2048, DFF = 3072, UPC = 6144;
constexpr int NTHR = 512;
constexpr int LDS_BYTES = 144 * 1024;
constexpr float EPS = 1e-6f;

constexpr size_t MB = 1024 * 1024;
constexpr size_t WS_WIN = 0, WS_WOUT = 4 * MB, WS_WUP = 6 * MB, WS_WDOWN = 18 * MB;
constexpr size_t WS_WR = 24 * MB, WS_WI = 24 * MB + 65536, WS_WSP = 24 * MB + 131072, WS_MOD = 24 * MB + 262144;
constexpr size_t WS_AGGA = 24 * MB + 393216, WS_AGGH = 24 * MB + 917504, WS_BAR = 24 * MB + 1441792, WS_CNT = WS_BAR + 16384  , WS_ZERO_BYTES = 65536;
constexpr size_t WS_XBUF = 192 * MB;
constexpr size_t WS_HALO = 26 * MB, WS_H = 32 * MB, WS_Y = 64 * MB, WS_Z = 96 * MB, WS_YCAT = 160 * MB, WS_ACT = 96 * MB;

struct Params { const float* in[27]; float* out; unsigned char* ws; };

__device__ __forceinline__ unsigned pk_bf16(float lo, float hi) { unsigned r; asm("v_cvt_pk_bf16_f32 %0, %1, %2" : "=v"(r) : "v"(lo), "v"(hi)); return r; }
__device__ __forceinline__ bf16_t f2bf(float f) { return (bf16_t)(pk_bf16(f, 0.f) & 0xffffu); }
__device__ __forceinline__ float bf2f(unsigned b) { return __uint_as_float(b << 16); }
__device__ __forceinline__ float bflo(unsigned w) { return __uint_as_float(w << 16); }
__device__ __forceinline__ float bfhi(unsigned w) { return __uint_as_float(w & 0xffff0000u); }
extern __shared__ __attribute__((aligned(16))) unsigned char smem[];
constexpr int WTAB_OFF = LDS_BYTES - 16 - 256;
__device__ __forceinline__ int hw_wave_slot() { return (int)(__builtin_amdgcn_s_getreg((5 << 11) | 4) & 63u); }
__device__ __forceinline__ int opaque_tid() {
    int w = *(const volatile LAS int*)((LAS unsigned char*)smem + WTAB_OFF + 4 * hw_wave_slot());
    int t = __builtin_amdgcn_readfirstlane(w) * 64 + (int)__builtin_amdgcn_mbcnt_hi(~0u, __builtin_amdgcn_mbcnt_lo(~0u, 0u));
    asm volatile("" : "+v"(t)); return t;
}
template <int CTRL> __device__ __forceinline__ float dpp_mov(float v) { return __int_as_float(__builtin_amdgcn_update_dpp(0, __float_as_int(v), CTRL, 0xf, 0xf, true)); }
__device__ __forceinline__ float wave_sum(float v) {
    v += dpp_mov<0xB1>(v); v += dpp_mov<0x4E>(v); v += dpp_mov<0x141>(v); v += dpp_mov<0x140>(v);
    const int iv = __float_as_int(v);
    return (__int_as_float(__builtin_amdgcn_readlane(iv, 0)) + __int_as_float(__builtin_amdgcn_readlane(iv, 16))) +
           (__int_as_float(__builtin_amdgcn_readlane(iv, 32)) + __int_as_float(__builtin_amdgcn_readlane(iv, 48)));
}
typedef _Float16 h16x2 __attribute__((ext_vector_type(2)));
__device__ __forceinline__ float gelu_t(float x) {
    const float u = 0.7978845608028654f * (x + 0.044715f * x * x * x);
    const float e = __builtin_amdgcn_exp2f(-2.885390081777927f * u);
    return x * __builtin_amdgcn_rcpf(1.0f + e);
}
__device__ __forceinline__ f32x2 gelu2(f32x2 x) {
    const f32x2 t = x * x;
    const f32x2 a = x * (t * (-2.885390081777927f * 0.7978845608028654f * 0.044715f) + (-2.885390081777927f * 0.7978845608028654f));
    f32x2 e; e.x = __builtin_amdgcn_exp2f(a.x); e.y = __builtin_amdgcn_exp2f(a.y);
    const f32x2 d = e + 1.0f;
    f32x2 r; r.x = __builtin_amdgcn_rcpf(d.x); r.y = __builtin_amdgcn_rcpf(d.y);
    return x * r;
}
__device__ __forceinline__ float sigmoid_f(float x) { return __builtin_amdgcn_rcpf(1.0f + __builtin_amdgcn_exp2f(-1.4426950408889634f * x)); }


#define XB_TMO      128
#define XB_XCNT(j)  (256  + 64 * (j))
#define XB_XSUB(j)  (1280 + 64 * (j))
#define XB_XGEN(j)  (2304 + 64 * (j))
#define XB_TOP      3328
#define XB_TOPGEN   3392
#define XCD_BAR_WORDS 3456
#define XB_SPIN_CAP (1u << 20)
__device__ __forceinline__ unsigned xb_ld(unsigned* p)              { return __hip_atomic_load(p, __ATOMIC_RELAXED, __HIP_MEMORY_SCOPE_AGENT); }
__device__ __forceinline__ unsigned xb_add(unsigned* p, unsigned v) { return __hip_atomic_fetch_add(p, v, __ATOMIC_RELAXED, __HIP_MEMORY_SCOPE_AGENT); }
__device__ __forceinline__ unsigned xb_xcc_id() { return (unsigned)__builtin_amdgcn_s_getreg((3 << 11) | 20) & 0xFu; }
#define XB_SPIN(cond, bar) do { unsigned _sp = 0; while (cond) { __builtin_amdgcn_s_sleep(1); \
    if ((++_sp & 255u) == 0u) { if (xb_ld(&(bar)[XB_TMO])) break; if (_sp > XB_SPIN_CAP) { atomicAdd(&(bar)[XB_TMO], 1u); break; } } } } while (0)
struct XcdBarrier { unsigned* bar; unsigned x; volatile LAS unsigned* st; };
__device__ __forceinline__ XcdBarrier xcd_barrier_post(unsigned* bar, volatile LAS unsigned* st) {
    XcdBarrier b; b.bar = bar; b.x = xb_xcc_id(); b.st = st;
    if (threadIdx.x == 0) st[2] = xb_add(&bar[XB_XCNT(b.x)], 1u);
    return b;
}
__device__ __forceinline__ void xcd_barrier_complete(unsigned* bar, unsigned x, unsigned& nloc, unsigned& nx) {
    const unsigned G = gridDim.x * gridDim.y * gridDim.z;
    unsigned sum, cnt, mine, sp = 0u;
    for (;;) {
        sum = 0u; cnt = 0u; mine = 0u;
#pragma unroll
        for (unsigned j = 0; j < 16; ++j) { const unsigned c = xb_ld(&bar[XB_XCNT(j)]); sum += c; cnt += (c > 0u) ? 1u : 0u; mine = (j == x) ? c : mine; }
        if (sum == G) break;
        __builtin_amdgcn_s_sleep(1);
        if ((++sp & 255u) == 0u) { if (xb_ld(&bar[XB_TMO])) break; if (sp > XB_SPIN_CAP) { atomicAdd(&bar[XB_TMO], 1u); break; } }
    }
    nloc = mine > 0u ? mine : 1u; nx = cnt > 0u ? cnt : 1u;
}
__device__ __forceinline__ void xcd_barrier(const XcdBarrier& b) {
    asm volatile("s_waitcnt vmcnt(0)" ::: "memory");
    __syncthreads();
    if (opaque_tid() == 0) {
        unsigned* bar = b.bar;
        __builtin_amdgcn_s_waitcnt(0);
        unsigned nloc = b.st[0], nx = b.st[1];
        if (nloc == 0u) { xcd_barrier_complete(bar, b.x, nloc, nx); b.st[0] = nloc; b.st[1] = nx; }
        const unsigned old = xb_add(&bar[XB_XSUB(b.x)], 1u);
        const unsigned gen = old / nloc;
        if (old + 1u == (gen + 1u) * nloc) {
            __builtin_amdgcn_fence(__ATOMIC_RELEASE, "agent");
            asm volatile("s_waitcnt vmcnt(0)" ::: "memory");
            const unsigned og = xb_add(&bar[XB_TOP], 1u);
            const unsigned tg = og / nx;
            if (og + 1u == (tg + 1u) * nx) xb_add(&bar[XB_TOPGEN], 1u);
            else XB_SPIN(xb_ld(&bar[XB_TOPGEN]) == tg, bar);
            __builtin_amdgcn_fence(__ATOMIC_ACQUIRE, "agent");
            xb_add(&bar[XB_XGEN(b.x)], 1u);
            asm volatile("s_waitcnt vmcnt(0)" ::: "memory");
        } else {
            XB_SPIN(xb_ld(&bar[XB_XGEN(b.x)]) == gen, bar);
            __builtin_amdgcn_fence(__ATOMIC_ACQUIRE, "agent");
            asm volatile("s_waitcnt vmcnt(0)" ::: "memory");
        }
    }
    __syncthreads();
}

constexpr int HTB = 16384;
__device__ __forceinline__ int lds_byte(int r, int c) { const int st = (r >> 4) * 2 + (c >> 5), rr = r & 15, cc = c & 31, ob = rr * 64 + cc * 2; return st * 1024 + (ob ^ (((ob >> 9) & 1) << 5)); }
__device__ __forceinline__ void stage_rc(int b, int& R, int& C) { const int st = b / 1024, sb = b % 1024, swz = sb ^ (((sb >> 9) & 1) << 5); R = (st >> 1) * 16 + swz / 64; C = (st & 1) * 32 + (swz % 64) / 2; }

struct UnitOrder {
    int nM, nN, nwg, G, c;
    __device__ __forceinline__ void init(int M, int N, int G_, int c_) { nM = M >> 8; nN = N >> 8; nwg = nM * nN; G = G_; c = c_; }
    __device__ __forceinline__ bool next(int i, int& pm, int& pn) const {
        const long L = (long)i * G + c; if (L >= nwg) return false;
        int wgid = (int)L; { const int q = nwg / 8, r = nwg % 8, xcd = wgid % 8, off = wgid / 8; wgid = (xcd < r ? xcd * (q + 1) : r * (q + 1) + (xcd - r) * q) + off; }
        const int nig = 8 * nN, gid = wgid / nig, fm = gid * 8, gsz = (nM - fm) < 8 ? (nM - fm) : 8;
        pm = fm + ((wgid % nig) % gsz); pn = (wgid % nig) / gsz; return true;
    }
};
template <class Epi>
__device__ __forceinline__ void gemm_phase(LAS unsigned char* lds, const bf16_t* __restrict__ A, const bf16_t* __restrict__ Bt, const int M, const int N, const int K, const int vcu, const Epi& epi) {
    const int tid = opaque_tid(), wid = __builtin_amdgcn_readfirstlane(tid >> 6), lane = tid & 63, wr = wid >> 2, wc = wid & 3, fr = lane & 15, fq = lane >> 4;
    const int nt = K / 64;
    unsigned voffB[2], voffA[2];
#pragma unroll
    for (int i = 0; i < 2; ++i) { int r, c; stage_rc(tid * 16 + i * 8192, r, c); const int rb = (r & ~31) + 8 * ((r & 15) >> 2) + 4 * ((r >> 4) & 1) + (r & 3); voffB[i] = (unsigned)(rb * K + c) * 2u; const int ra = Epi::PERMA ? ((r & 64) | ((r & 15) << 2) | ((r >> 4) & 3)) : r; voffA[i] = (unsigned)(ra * K + c) * 2u; }
    const size_t kstep = 128, hstep = (size_t)128 * K * 2, tstep = 2 * hstep;
    const unsigned ldsbase = (unsigned)__builtin_amdgcn_readfirstlane((int)(unsigned)(unsigned long)lds) + (unsigned)wid * 1024u;
    const int aoff = lds_byte(wr * 64 + fr, fq * 8), boff = lds_byte(wc * 32 + fr, fq * 8);
#define SA(b, h) (((b) * 2 + (h)) * HTB)
#define SB(b, h) ((4 + (b) * 2 + (h)) * HTB)
#define STAGE(bufoff, gbase, VO) do { const char* _g = (gbase); const unsigned _m0 = ldsbase + (unsigned)(bufoff); unsigned _keep; \
    asm volatile("s_mov_b32 %0, m0\n\ts_mov_b32 m0, %3\n\ts_nop 0\n\tglobal_load_lds_dwordx4 %1, %2\n\ts_add_u32 m0, m0, 0x2000\n\ts_nop 0\n\tglobal_load_lds_dwordx4 %4, %2\n\ts_mov_b32 m0, %0" \
                 : "=&s"(_keep) : "v"(VO[0]), "s"(_g), "s"(_m0), "v"(VO[1]) : "memory"); } while (0)
#define LDA(dst, b, h) do { _Pragma("unroll") for (int m = 0; m < 4; ++m) _Pragma("unroll") for (int k = 0; k < 2; ++k) dst[m][k] = *(const LAS bf16x8*)(lds + SA(b, h) + aoff + m * 2048 + k * 1024); } while (0)
#define LDB(dst, b, h) do { _Pragma("unroll") for (int n = 0; n < 2; ++n) _Pragma("unroll") for (int k = 0; k < 2; ++k) dst[n][k] = *(const LAS bf16x8*)(lds + SB(b, h) + boff + n * 2048 + k * 1024); } while (0)
#define MMA(ai, bj, At_, Bt_) do { __builtin_amdgcn_s_setprio(1); \
    _Pragma("unroll") for (int m = 0; m < 4; ++m) _Pragma("unroll") for (int n = 0; n < 2; ++n) _Pragma("unroll") for (int k = 0; k < 2; ++k) \
      acc[ai][bj][m][n] = __builtin_amdgcn_mfma_f32_16x16x32_bf16(Bt_[n][k], At_[m][k], acc[ai][bj][m][n], 0, 0, 0); \
    __builtin_amdgcn_s_setprio(0); } while (0)
#define WAIT_V(n) asm volatile("s_waitcnt vmcnt(" #n ")" ::: "memory")
#define WAIT_L(n) asm volatile("s_waitcnt lgkmcnt(" #n ")" ::: "memory")
#define BAR __builtin_amdgcn_s_barrier()
#define SCHED __builtin_amdgcn_sched_barrier(0)
#define ZERO_ACC() do { _Pragma("unroll") for (int a = 0; a < 2; ++a) _Pragma("unroll") for (int b = 0; b < 2; ++b) _Pragma("unroll") for (int m = 0; m < 4; ++m) _Pragma("unroll") for (int n = 0; n < 2; ++n) acc[a][b][m][n] = (f32x4){0.f, 0.f, 0.f, 0.f}; } while (0)
    UnitOrder S; S.init(M, N, (int)gridDim.x, vcu);
    int cpm, cpn, npm = 0, npn = 0, ui = 0;
    if (!S.next(0, cpm, cpn)) return;
    epi.prefetch(cpn, lds);
    WAIT_V(0); WAIT_L(0); __syncthreads();
    f32x4 acc[2][2][4][2];
    ZERO_ACC();
    bf16x8 At[4][2], B0[2][2], B1[2][2];
    const char* cA = (const char*)A + (size_t)cpm * tstep; const char* cB = (const char*)Bt + (size_t)cpn * tstep;
    STAGE(SB(0, 0), cB, voffB); STAGE(SB(0, 1), cB + hstep, voffB);
    epi.mid_prologue(cpm);
    STAGE(SA(0, 0), cA, voffA); STAGE(SA(0, 1), cA + hstep, voffA);
    if (wr == 1) BAR;
    WAIT_V(2); BAR;
    STAGE(SB(1, 0), cB + kstep, voffB); STAGE(SA(1, 0), cA + kstep, voffA); STAGE(SB(1, 1), cB + hstep + kstep, voffB);
    WAIT_V(6); BAR;
    for (;;) {
        const bool has_next = S.next(ui + 1, npm, npn);
        const char* nA = has_next ? (const char*)A + (size_t)npm * tstep : cA; const char* nB = has_next ? (const char*)Bt + (size_t)npn * tstep : cB;
        for (int t = 0; t < nt; t += 2) {
            const bool last = (t == nt - 2);
            const char* a1 = cA + (size_t)(t + 1) * kstep;
            const char* a2 = last ? nA : cA + (size_t)(t + 2) * kstep; const char* b2 = last ? nB : cB + (size_t)(t + 2) * kstep;
            const char* a3 = a2 + kstep; const char* b3 = b2 + kstep;
            LDB(B0, 0, 0); LDB(B1, 0, 1); SCHED; LDA(At, 0, 0); STAGE(SA(1, 1), a1 + hstep, voffA);
            WAIT_V(8); WAIT_L(0); BAR; MMA(0, 0, At, B0); MMA(0, 1, At, B1); BAR; SCHED;
            LDA(At, 0, 1); STAGE(SB(0, 0), b2, voffB); STAGE(SB(0, 1), b2 + hstep, voffB); STAGE(SA(0, 0), a2, voffA);
            WAIT_V(8); WAIT_L(0); BAR; MMA(1, 0, At, B0); MMA(1, 1, At, B1); BAR; SCHED;
            LDB(B0, 1, 0); LDB(B1, 1, 1); SCHED; LDA(At, 1, 0); STAGE(SA(0, 1), a2 + hstep, voffA);
            WAIT_V(8); WAIT_L(0); BAR; MMA(0, 0, At, B0); MMA(0, 1, At, B1); BAR; SCHED;
            LDA(At, 1, 1); STAGE(SB(1, 0), b3, voffB); STAGE(SB(1, 1), b3 + hstep, voffB); STAGE(SA(1, 0), a3, voffA);
            WAIT_V(8); WAIT_L(0); BAR; MMA(1, 0, At, B0); MMA(1, 1, At, B1); BAR; SCHED;
        }
        if (Epi::ALIGN) { if (wr == 0) BAR; }
        if (!Epi::AFTER_DRAIN) epi(acc, cpm, cpn, has_next ? npn : -1, lds);
        if (!has_next) break;
        ZERO_ACC();
        cpm = npm; cpn = npn; cA = nA; cB = nB; ++ui;
        if (Epi::ALIGN) { if (wr == 1) BAR; }
    }
    WAIT_V(0);
    if (!Epi::ALIGN) { if (wr == 0) BAR; }
    BAR;
    if (Epi::AFTER_DRAIN) epi(acc, cpm, cpn, -1, lds);
    WAIT_V(0); WAIT_L(0); __syncthreads();
#undef SA
#undef SB
#undef STAGE
#undef LDA
#undef LDB
#undef MMA
#undef ZERO_ACC
}

struct EpiBf16 {
    static constexpr bool PERMA = false, AFTER_DRAIN = false, ALIGN = false;
    bf16_t* O; int ldc; int gelu_from;
    __device__ __forceinline__ void prefetch(int, LAS unsigned char*) const {}
    __device__ __forceinline__ void mid_prologue(int) const {}
    __device__ __forceinline__ void operator()(f32x4 (&acc)[2][2][4][2], int pm, int pn, int, LAS unsigned char*) const {
        const int tid = opaque_tid(), wid = tid >> 6, lane = tid & 63, wr = wid >> 2, wc = wid & 3, fr = lane & 15, fq = lane >> 4;
        const bool g = pn >= gelu_from;
#pragma unroll
        for (int ai = 0; ai < 2; ++ai)
#pragma unroll
            for (int m = 0; m < 4; ++m) {
                bf16_t* rowp = O + (size_t)(pm * 256 + ai * 128 + wr * 64 + m * 16 + fr) * ldc + pn * 256 + wc * 32 + 8 * fq;
#pragma unroll
                for (int bj = 0; bj < 2; ++bj) {
                    f32x4 v0 = acc[ai][bj][m][0], v1 = acc[ai][bj][m][1];
                    if (g) { const f32x2 a = gelu2((f32x2){v0[0], v0[1]}), b = gelu2((f32x2){v0[2], v0[3]}), c = gelu2((f32x2){v1[0], v1[1]}), d = gelu2((f32x2){v1[2], v1[3]});
                             v0 = (f32x4){a.x, a.y, b.x, b.y}; v1 = (f32x4){c.x, c.y, d.x, d.y}; }
                    u32x4 w; w.x = pk_bf16(v0[0], v0[1]); w.y = pk_bf16(v0[2], v0[3]); w.z = pk_bf16(v1[0], v1[1]); w.w = pk_bf16(v1[2], v1[3]);
                    *(u32x4*)(rowp + bj * 128) = w;
                }
            }
    }
};

#define DPP_SHR1 0x111
constexpr int CWL_OFF = 131072;
constexpr int HB_OFF = 135168;
struct EpiUp {
    static constexpr bool PERMA = true, AFTER_DRAIN = false, ALIGN = true;
    bf16_t* act; float* halo; const float* cw; const float* cb;
    __device__ __forceinline__ void mid_prologue(int) const {}
    __device__ __forceinline__ void prefetch(int pn, LAS unsigned char* lds) const {
        const int t = opaque_tid();
        if (t < 256) {
            const int arr = t >> 6, c4 = (t & 63) * 4, oc = (c4 >> 7) * 3072 + pn * 128 + (c4 & 127);
            const f32x4 v = *(const f32x4*)((arr < 3 ? cw + arr * UPC : cb) + oc);
            *(LAS f32x4*)(lds + CWL_OFF + (arr * 256 + c4) * 4) = v;
        }
    }
    __device__ __forceinline__ void operator()(f32x4 (&acc)[2][2][4][2], int pm, int pn, int nxt_pn, LAS unsigned char* lds) const {
        const int tid = opaque_tid(), wid = tid >> 6, lane = tid & 63, wr = wid >> 2, wc = wid & 3, fr = lane & 15, fq = lane >> 4;
        LAS float* Hb = (LAS float*)(lds + HB_OFF);
        f32x4 nxt_cw = (f32x4){0.f, 0.f, 0.f, 0.f};
        if (nxt_pn >= 0 && tid < 256) { const int arr = tid >> 6, c4 = (tid & 63) * 4, oc = (c4 >> 7) * 3072 + nxt_pn * 128 + (c4 & 127); nxt_cw = *(const f32x4*)((arr < 3 ? cw + arr * UPC : cb) + oc); }
        const int tc = wc * 32 + 8 * fq;
        if (fr == 15) {
#pragma unroll
            for (int ai = 0; ai < 2; ++ai)
#pragma unroll
                for (int bj = 0; bj < 2; ++bj)
#pragma unroll
                    for (int n = 0; n < 2; ++n) {
                        *(LAS f32x4*)(Hb + ((ai * 2 + wr) * 2 + 0) * 256 + bj * 128 + n * 4 + tc) = acc[ai][bj][2][n];
                        *(LAS f32x4*)(Hb + ((ai * 2 + wr) * 2 + 1) * 256 + bj * 128 + n * 4 + tc) = acc[ai][bj][3][n];
                    }
        }
        {
            float* hg = halo + (size_t)pm * 4 * UPC + (size_t)pn * 256 + tc;
            if (wr == 0 && fr == 0) {
#pragma unroll
                for (int bj = 0; bj < 2; ++bj)
#pragma unroll
                    for (int n = 0; n < 2; ++n) { *(f32x4*)(hg + bj * 128 + n * 4) = acc[0][bj][0][n]; *(f32x4*)(hg + UPC + bj * 128 + n * 4) = acc[0][bj][1][n]; }
            }
            if (wr == 1 && fr == 15) {
#pragma unroll
                for (int bj = 0; bj < 2; ++bj)
#pragma unroll
                    for (int n = 0; n < 2; ++n) { *(f32x4*)(hg + 2 * UPC + bj * 128 + n * 4) = acc[1][bj][2][n]; *(f32x4*)(hg + 3 * UPC + bj * 128 + n * 4) = acc[1][bj][3][n]; }
            }
        }
        __syncthreads();
#pragma unroll
        for (int ai = 0; ai < 2; ++ai) {
            const int s = ai * 2 + wr;
            u32x2 wq[2][4];
#pragma unroll
            for (int n = 0; n < 2; ++n) {
                f32x4 res[2][4];
#pragma unroll
                for (int bj = 0; bj < 2; ++bj) {
                    const LAS float* cwl = (const LAS float*)(lds + CWL_OFF) + bj * 128 + n * 4 + tc;
                    const f32x4 w0 = *(const LAS f32x4*)cwl, w1 = *(const LAS f32x4*)(cwl + 256), w2 = *(const LAS f32x4*)(cwl + 512), bb = *(const LAS f32x4*)(cwl + 768);
                    f32x4 h2 = (f32x4){0.f, 0.f, 0.f, 0.f}, h3 = h2;
                    if (s > 0 && fr == 0) { h2 = *(const LAS f32x4*)(Hb + ((s - 1) * 2 + 0) * 256 + bj * 128 + n * 4 + tc); h3 = *(const LAS f32x4*)(Hb + ((s - 1) * 2 + 1) * 256 + bj * 128 + n * 4 + tc); }
                    const f32x4 x0 = acc[ai][bj][0][n], x1 = acc[ai][bj][1][n], x2 = acc[ai][bj][2][n], x3 = acc[ai][bj][3][n];
                    f32x4 p2, p3;
#pragma unroll
                    for (int e = 0; e < 4; ++e) {
                        p2[e] = __int_as_float(__builtin_amdgcn_update_dpp(__float_as_int(h2[e]), __float_as_int(x2[e]), DPP_SHR1, 0xf, 0xf, false));
                        p3[e] = __int_as_float(__builtin_amdgcn_update_dpp(__float_as_int(h3[e]), __float_as_int(x3[e]), DPP_SHR1, 0xf, 0xf, false));
                    }
                    res[bj][0] = w2 * x0 + w1 * p3 + w0 * p2 + bb;
                    res[bj][1] = w2 * x1 + w1 * x0 + w0 * p3 + bb;
                    res[bj][2] = w2 * x2 + w1 * x1 + w0 * x0 + bb;
                    res[bj][3] = w2 * x3 + w1 * x2 + w0 * x1 + bb;
                }
#pragma unroll
                for (int m = 0; m < 4; ++m) {
                    const f32x4 g = res[0][m], v = res[1][m];
                    const f32x2 lo = gelu2((f32x2){g[0], g[1]}) * (f32x2){v[0], v[1]}, hi = gelu2((f32x2){g[2], g[3]}) * (f32x2){v[2], v[3]};
                    wq[n][m].x = pk_bf16(lo.x, lo.y); wq[n][m].y = pk_bf16(hi.x, hi.y);
                }
            }
#pragma unroll
            for (int m = 0; m < 4; ++m) {
                u32x4 w; w.x = wq[0][m].x; w.y = wq[0][m].y; w.z = wq[1][m].x; w.w = wq[1][m].y;
                *(u32x4*)(act + (size_t)(pm * 256 + ai * 128 + wr * 64 + 4 * fr + m) * DFF + pn * 128 + tc) = w;
            }
        }
        __syncthreads();
        if (nxt_pn >= 0 && tid < 256) *(LAS f32x4*)(lds + CWL_OFF + ((tid >> 6) * 256 + (tid & 63) * 4) * 4) = nxt_cw;
    }
};

struct RowX { float* xbuf; unsigned* cnt; };
__device__ __forceinline__ void row_exchange(float (&part)[2][4], float (&rstd)[2][4], const RowX& X, int pm, int pn, LAS unsigned char* lds, int tid) {
    const int wid = tid >> 6, lane = tid & 63, wr = wid >> 2, wc = wid & 3, fr = lane & 15, fq = lane >> 4;
    LAS float* P = (LAS float*)lds;
    LAS float* S = (LAS float*)(lds + 4096);
#pragma unroll
    for (int ai = 0; ai < 2; ++ai)
#pragma unroll
        for (int m = 0; m < 4; ++m) {
            float v = part[ai][m];
            v += __shfl_xor(v, 16); v += __shfl_xor(v, 32);
            if (fq == 0) P[(ai * 128 + wr * 64 + m * 16 + fr) * 4 + wc] = v;
        }
    asm volatile("s_waitcnt lgkmcnt(0)" ::: "memory"); __syncthreads();
    if (tid < 256) {
        const f32x4 a = *(const LAS f32x4*)(P + tid * 4);
        __hip_atomic_store(X.xbuf + ((size_t)pm * 256 + tid) * 4 + pn, (a[0] + a[1]) + (a[2] + a[3]), __ATOMIC_RELAXED, __HIP_MEMORY_SCOPE_AGENT);
    }
    asm volatile("s_waitcnt vmcnt(0)" ::: "memory");
    if (lane == 0 && wid < 4) __hip_atomic_fetch_add(X.cnt + 64 * pm, 1u, __ATOMIC_RELAXED, __HIP_MEMORY_SCOPE_AGENT);
    if (wid == 0) {
        unsigned sp = 0;
        while ((unsigned)__builtin_amdgcn_readfirstlane((int)__hip_atomic_load(X.cnt + 64 * pm, __ATOMIC_RELAXED, __HIP_MEMORY_SCOPE_AGENT)) < 16u) { __builtin_amdgcn_s_sleep(4); if (++sp > (1u << 20)) break; }
    }
    asm volatile("s_waitcnt vmcnt(0) lgkmcnt(0)" ::: "memory"); __syncthreads();
    if (tid < 256) {
        const float* sl = X.xbuf + ((size_t)pm * 256 + tid) * 4;
        const float t = (__hip_atomic_load(sl, __ATOMIC_RELAXED, __HIP_MEMORY_SCOPE_AGENT) + __hip_atomic_load(sl + 1, __ATOMIC_RELAXED, __HIP_MEMORY_SCOPE_AGENT)) +
                        (__hip_atomic_load(sl + 2, __ATOMIC_RELAXED, __HIP_MEMORY_SCOPE_AGENT) + __hip_atomic_load(sl + 3, __ATOMIC_RELAXED, __HIP_MEMORY_SCOPE_AGENT));
        S[tid] = rsqrtf(t * (1.0f / DM) + EPS);
    }
    asm volatile("s_waitcnt lgkmcnt(0)" ::: "memory"); __syncthreads();
#pragma unroll
    for (int ai = 0; ai < 2; ++ai)
#pragma unroll
        for (int m = 0; m < 4; ++m) rstd[ai][m] = S[ai * 128 + wr * 64 + m * 16 + fr];
}
__device__ __forceinline__ f32x4 unpack4(const u32x2 w) { return (f32x4){bflo(w.x), bfhi(w.x), bflo(w.y), bfhi(w.y)}; }
__device__ __forceinline__ float ssq4v(const f32x4& v) { return v[0] * v[0] + v[1] * v[1] + v[2] * v[2] + v[3] * v[3]; }

struct EpiMixOut {
    static constexpr bool PERMA = false, AFTER_DRAIN = true, ALIGN = false;
    const float* x; bf16_t* x1b; bf16_t* h; const float* mod; const float* gpost; const float* gpre; RowX X1, X2;
    __device__ __forceinline__ void prefetch(int, LAS unsigned char*) const {}
    __device__ __forceinline__ void mid_prologue(int) const {}
    __device__ __forceinline__ void operator()(f32x4 (&acc)[2][2][4][2], int pm, int pn, int, LAS unsigned char* lds) const {
        const int tid = opaque_tid(), wid = tid >> 6, lane = tid & 63, wr = wid >> 2, wc = wid & 3, fr = lane & 15, fq = lane >> 4;
        const int b = pm >> 4;
        float part[2][4], rs[2][4];
#pragma unroll
        for (int ai = 0; ai < 2; ++ai)
#pragma unroll
            for (int m = 0; m < 4; ++m) part[ai][m] = (ssq4v(acc[ai][0][m][0]) + ssq4v(acc[ai][0][m][1])) + (ssq4v(acc[ai][1][m][0]) + ssq4v(acc[ai][1][m][1]));
        const int col0 = pn * 256 + wc * 32 + 8 * fq;
        {
            f32x4 xv[4][2][2];
#pragma unroll
            for (int m = 0; m < 4; ++m) {
                const float* xr = (const float*)((const char*)x + (unsigned)((pm * 256 + wr * 64 + m * 16 + fr) * DM + col0) * 4u);
#pragma unroll
                for (int bj = 0; bj < 2; ++bj)
#pragma unroll
                    for (int n = 0; n < 2; ++n) xv[m][bj][n] = __builtin_nontemporal_load((const f32x4*)(xr + bj * 128 + n * 4));
            }
            row_exchange(part, rs, X1, pm, pn, lds, tid);
            f32x4 gp[2][2];
#pragma unroll
            for (int bj = 0; bj < 2; ++bj)
#pragma unroll
                for (int n = 0; n < 2; ++n) gp[bj][n] = *(const f32x4*)(gpost + col0 + bj * 128 + n * 4) * *(const f32x4*)(mod + b * UPC + 2048 + col0 + bj * 128 + n * 4);
#pragma unroll
            for (int ai = 0; ai < 2; ++ai)
#pragma unroll
                for (int m = 0; m < 4; ++m) {
                    const unsigned ro = (unsigned)((pm * 256 + ai * 128 + wr * 64 + m * 16 + fr) * DM + col0) * 4u;
                    bf16_t* orow = (bf16_t*)((char*)x1b + (ro >> 1));
#pragma unroll
                    for (int bj = 0; bj < 2; ++bj) {
                        u32x4 w;
#pragma unroll
                        for (int n = 0; n < 2; ++n) {
                            const f32x4 o = xv[m][bj][n] + gp[bj][n] * (acc[ai][bj][m][n] * rs[ai][m]);
                            acc[ai][bj][m][n] = o;
                            if (n == 0) { w.x = pk_bf16(o[0], o[1]); w.y = pk_bf16(o[2], o[3]); } else { w.z = pk_bf16(o[0], o[1]); w.w = pk_bf16(o[2], o[3]); }
                        }
                        *(u32x4*)(orow + bj * 128) = w;
                    }
                    if (ai == 0) {
                        const float* xr = (const float*)((const char*)x + ro + 128u * DM * 4u);
#pragma unroll
                        for (int bj = 0; bj < 2; ++bj)
#pragma unroll
                            for (int n = 0; n < 2; ++n) xv[m][bj][n] = __builtin_nontemporal_load((const f32x4*)(xr + bj * 128 + n * 4));
                    }
                    __builtin_amdgcn_sched_barrier(0);
                }
        }
#pragma unroll
        for (int ai = 0; ai < 2; ++ai)
#pragma unroll
            for (int m = 0; m < 4; ++m) part[ai][m] = (ssq4v(acc[ai][0][m][0]) + ssq4v(acc[ai][0][m][1])) + (ssq4v(acc[ai][1][m][0]) + ssq4v(acc[ai][1][m][1]));
        row_exchange(part, rs, X2, pm, pn, lds, tid);
        {
            f32x4 gs[2][2], sh[2][2];
#pragma unroll
            for (int bj = 0; bj < 2; ++bj)
#pragma unroll
                for (int n = 0; n < 2; ++n) {
                    const int col = col0 + bj * 128 + n * 4;
                    gs[bj][n] = *(const f32x4*)(gpre + col) * (1.0f + *(const f32x4*)(mod + b * UPC + 4096 + col)); sh[bj][n] = *(const f32x4*)(mod + b * UPC + 3072 + col);
                }
#pragma unroll
            for (int ai = 0; ai < 2; ++ai)
#pragma unroll
                for (int m = 0; m < 4; ++m) {
                    const unsigned ro = (unsigned)((pm * 256 + ai * 128 + wr * 64 + m * 16 + fr) * DM + col0) * 2u;
                    bf16_t* hr = (bf16_t*)((char*)h + ro);
#pragma unroll
                    for (int bj = 0; bj < 2; ++bj) {
                        const f32x4 o0 = acc[ai][bj][m][0] * rs[ai][m] * gs[bj][0] + sh[bj][0], o1 = acc[ai][bj][m][1] * rs[ai][m] * gs[bj][1] + sh[bj][1];
                        u32x4 w; w.x = pk_bf16(o0[0], o0[1]); w.y = pk_bf16(o0[2], o0[3]); w.z = pk_bf16(o1[0], o1[1]); w.w = pk_bf16(o1[2], o1[3]);
                        *(u32x4*)(hr + bj * 128) = w;
                    }
                    __builtin_amdgcn_sched_barrier(0);
                }
        }
        __syncthreads();
    }
};

__device__ __forceinline__ void fixup_tile(const float* halo, const float* cw, const float* cb, bf16_t* act, int pm) {
    if ((pm & 15) == 0) return;
    const float* hp = halo + (size_t)(pm - 1) * 4 * UPC; const float* hc = halo + (size_t)pm * 4 * UPC;
    for (int i = opaque_tid(); i < DFF / 4; i += NTHR) {
        const int c4 = i * 4, gi = (c4 >> 7) * 256 + (c4 & 127);
        f32x4 r0[2], r1[2];
#pragma unroll
        for (int hv = 0; hv < 2; ++hv) {
            const int ti = gi + hv * 128, oc = hv * 3072 + c4;
            const f32x4 um2 = *(const f32x4*)(hp + 2 * UPC + ti), um1 = *(const f32x4*)(hp + 3 * UPC + ti), u0 = *(const f32x4*)(hc + ti), u1 = *(const f32x4*)(hc + UPC + ti);
            const f32x4 w0 = *(const f32x4*)(cw + oc), w1 = *(const f32x4*)(cw + UPC + oc), w2 = *(const f32x4*)(cw + 2 * UPC + oc), bb = *(const f32x4*)(cb + oc);
            r0[hv] = w0 * um2 + w1 * um1 + w2 * u0 + bb;
            r1[hv] = w0 * um1 + w1 * u0 + w2 * u1 + bb;
        }
        u32x2 a, b;
        a.x = pk_bf16(gelu_t(r0[0][0]) * r0[1][0], gelu_t(r0[0][1]) * r0[1][1]); a.y = pk_bf16(gelu_t(r0[0][2]) * r0[1][2], gelu_t(r0[0][3]) * r0[1][3]);
        b.x = pk_bf16(gelu_t(r1[0][0]) * r1[1][0], gelu_t(r1[0][1]) * r1[1][1]); b.y = pk_bf16(gelu_t(r1[0][2]) * r1[1][2], gelu_t(r1[0][3]) * r1[1][3]);
        *(u32x2*)(act + (size_t)(pm * 256) * DFF + c4) = a;
        *(u32x2*)(act + (size_t)(pm * 256 + 1) * DFF + c4) = b;
    }
}

struct EpiDownOut {
    static constexpr bool PERMA = false, AFTER_DRAIN = true, ALIGN = false;
    float* out; const bf16_t* x1b; const float* mod; const float* gpost; RowX X; const float* halo; const float* cw; const float* cb; bf16_t* act;
    __device__ __forceinline__ void prefetch(int, LAS unsigned char*) const {}
    __device__ __forceinline__ void mid_prologue(int pm) const {
        fixup_tile(halo, cw, cb, act, pm);
        asm volatile("s_waitcnt vmcnt(0)" ::: "memory"); __syncthreads();
    }
    __device__ __forceinline__ void operator()(f32x4 (&acc)[2][2][4][2], int pm, int pn, int, LAS unsigned char* lds) const {
        const int tid = opaque_tid(), wid = tid >> 6, lane = tid & 63, wr = wid >> 2, wc = wid & 3, fr = lane & 15, fq = lane >> 4;
        const int b = pm >> 4;
        float part[2][4], rs[2][4];
#pragma unroll
        for (int ai = 0; ai < 2; ++ai)
#pragma unroll
            for (int m = 0; m < 4; ++m) part[ai][m] = (ssq4v(acc[ai][0][m][0]) + ssq4v(acc[ai][0][m][1])) + (ssq4v(acc[ai][1][m][0]) + ssq4v(acc[ai][1][m][1]));
        const int col0 = pn * 256 + wc * 32 + 8 * fq;
        u32x2 xv[4][2][2];
#pragma unroll
        for (int r = 0; r < 4; ++r) {
            const bf16_t* xr = (const bf16_t*)((const char*)x1b + (unsigned)((pm * 256 + wr * 64 + r * 16 + fr) * DM + col0) * 2u);
#pragma unroll
            for (int bj = 0; bj < 2; ++bj)
#pragma unroll
                for (int n = 0; n < 2; ++n) xv[r][bj][n] = *(const u32x2*)(xr + bj * 128 + n * 4);
        }
        row_exchange(part, rs, X, pm, pn, lds, tid);
        f32x4 gp[2][2];
#pragma unroll
        for (int bj = 0; bj < 2; ++bj)
#pragma unroll
            for (int n = 0; n < 2; ++n) gp[bj][n] = *(const f32x4*)(gpost + col0 + bj * 128 + n * 4) * *(const f32x4*)(mod + b * UPC + 5120 + col0 + bj * 128 + n * 4);
#pragma unroll
        for (int r = 0; r < 8; ++r) {
            const int ai = r >> 2, m = r & 3;
            const unsigned ro = (unsigned)((pm * 256 + ai * 128 + wr * 64 + m * 16 + fr) * DM + col0) * 4u;
            float* orow = (float*)((char*)out + ro);
#pragma unroll
            for (int bj = 0; bj < 2; ++bj)
#pragma unroll
                for (int n = 0; n < 2; ++n) *(f32x4*)(orow + bj * 128 + n * 4) = unpack4(xv[r & 3][bj][n]) + gp[bj][n] * (acc[ai][bj][m][n] * rs[ai][m]);
            if (r + 4 < 8) {
                const bf16_t* xr = (const bf16_t*)((const char*)x1b + (unsigned)((pm * 256 + 128 + wr * 64 + m * 16 + fr) * DM + col0) * 2u);
#pragma unroll
                for (int bj = 0; bj < 2; ++bj)
#pragma unroll
                    for (int n = 0; n < 2; ++n) xv[r & 3][bj][n] = *(const u32x2*)(xr + bj * 128 + n * 4);
            }
            __builtin_amdgcn_sched_barrier(0);
        }
        __syncthreads();
    }
};

__device__ __forceinline__ void p0_transpose(LAS unsigned char* lds, const float* __restrict__ src, int ldn, bf16_t* __restrict__ dst, int ldk, int k0, int n0, int dstrow0) {
    LAS bf16_t* T = (LAS bf16_t*)lds;
    const int tid = opaque_tid();
    {
        const int k = tid >> 3, n8 = (tid & 7) * 8;
        const float* sp = src + (size_t)(k0 + k) * ldn + n0 + n8;
        const f32x4 v0 = *(const f32x4*)sp, v1 = *(const f32x4*)(sp + 4);
#pragma unroll
        for (int e = 0; e < 4; ++e) { T[(n8 + e) * 72 + k] = f2bf(v0[e]); T[(n8 + 4 + e) * 72 + k] = f2bf(v1[e]); }
    }
    __syncthreads();
    {
        const int n = tid >> 3, k8 = (tid & 7) * 8;
        const u32x4 o = *(const LAS u32x4*)(T + n * 72 + k8);
        *(u32x4*)(dst + (size_t)(dstrow0 + n) * ldk + k0 + k8) = o;
    }
    __syncthreads();
}
struct SuperItem { const float* src; bf16_t* dst; int ldn, ldk, k0, n0, up; };
__device__ __forceinline__ SuperItem p0_item(const Params& p, int idx) {
    SuperItem it;
    if (idx < 128)      { it.src = p.in[6];  it.dst = (bf16_t*)(p.ws + WS_WIN);   it.ldn = INC; it.ldk = DM;  it.k0 = (idx >> 3) * 64; it.n0 = (idx & 7) * 256; it.up = 0; }
    else if (idx < 192) { const int i = idx - 128; it.src = p.in[20]; it.dst = (bf16_t*)(p.ws + WS_WOUT);  it.ldn = DM;  it.ldk = DM;  it.k0 = (i >> 2) * 64; it.n0 = (i & 3) * 256; it.up = 0; }
    else if (idx < 576) { const int i = idx - 192; it.src = p.in[23]; it.dst = (bf16_t*)(p.ws + WS_WUP);   it.ldn = UPC; it.ldk = DM;  it.k0 = (i / 24) * 64; it.n0 = (i % 24) * 256; it.up = 1; }
    else                { const int i = idx - 576; it.src = p.in[26]; it.dst = (bf16_t*)(p.ws + WS_WDOWN); it.ldn = DM;  it.ldk = DFF; it.k0 = (i >> 2) * 64; it.n0 = (i & 3) * 256; it.up = 0; }
    return it;
}
__device__ __forceinline__ void p0_super_load(const SuperItem& it, int tid, f32x4 (&v)[4][2]) {
    const int k = tid >> 3, n8 = (tid & 7) * 8;
    const float* sp = it.src + (size_t)(it.k0 + k) * it.ldn + it.n0 + n8;
#pragma unroll
    for (int sb = 0; sb < 4; ++sb) { v[sb][0] = __builtin_nontemporal_load((const f32x4*)(sp + sb * 64)); v[sb][1] = __builtin_nontemporal_load((const f32x4*)(sp + sb * 64 + 4)); }
}
__device__ __forceinline__ void p0_super_store(LAS unsigned char* lds, const SuperItem& it, int tid, const f32x4 (&v)[4][2]) {
    LAS bf16_t* T = (LAS bf16_t*)lds;
    {
        const int k = tid >> 3, n8 = (tid & 7) * 8;
#pragma unroll
        for (int sb = 0; sb < 4; ++sb)
#pragma unroll
            for (int e = 0; e < 4; ++e) { T[sb * 4608 + (n8 + e) * 72 + k] = f2bf(v[sb][0][e]); T[sb * 4608 + (n8 + 4 + e) * 72 + k] = f2bf(v[sb][1][e]); }
    }
    __syncthreads();
    {
        const int n = tid >> 3, k8 = (tid & 7) * 8;
#pragma unroll
        for (int sb = 0; sb < 4; ++sb) {
            const int nn = it.n0 + sb * 64;
            int drow = nn;
            if (it.up) { const int half = nn / 3072, rem = nn % 3072; drow = (rem >> 7) * 256 + half * 128 + (rem & 127); }
            const u32x4 o = *(const LAS u32x4*)(T + sb * 4608 + n * 72 + k8);
            *(u32x4*)(it.dst + (size_t)(drow + n) * it.ldk + it.k0 + k8) = o;
        }
    }
    __syncthreads();
}

__device__ __forceinline__ void p0_mod(const Params& p, LAS unsigned char* lds, int item) {
    LAS float* sc = (LAS float*)lds; LAS float* red = (LAS float*)(lds + 16384);
    const int tid = opaque_tid();
    const float* c = p.in[1];
    for (int i = tid; i < 4096; i += NTHR) { const float v = c[i]; sc[i] = v * sigmoid_f(v); }
    __syncthreads();
    const int c4 = tid & 15, kr = tid >> 4, col = item * 64 + c4 * 4;
    const float* w = p.in[2];
    f32x4 a0 = {0.f, 0.f, 0.f, 0.f}, a1 = a0, a2 = a0, a3 = a0;
#pragma unroll 16
    for (int k = kr; k < 1024; k += 32) {
        const f32x4 wv = __builtin_nontemporal_load((const f32x4*)(w + (size_t)k * UPC + col));
        a0 += sc[k] * wv; a1 += sc[1024 + k] * wv; a2 += sc[2048 + k] * wv; a3 += sc[3072 + k] * wv;
    }
    *(LAS f32x4*)(red + (kr * 4 + 0) * 64 + c4 * 4) = a0; *(LAS f32x4*)(red + (kr * 4 + 1) * 64 + c4 * 4) = a1;
    *(LAS f32x4*)(red + (kr * 4 + 2) * 64 + c4 * 4) = a2; *(LAS f32x4*)(red + (kr * 4 + 3) * 64 + c4 * 4) = a3;
    __syncthreads();
    if (tid < 256) {
        const int b = tid >> 6, cc = tid & 63; float s = 0.f;
#pragma unroll 8
        for (int k2 = 0; k2 < 32; ++k2) s += red[(k2 * 4 + b) * 64 + cc];
        __hip_atomic_store((float*)(p.ws + WS_MOD) + b * UPC + item * 64 + cc, s + p.in[3][item * 64 + cc], __ATOMIC_RELAXED, __HIP_MEMORY_SCOPE_AGENT);
    }
    asm volatile("s_waitcnt vmcnt(0)" ::: "memory");
    __syncthreads();
    if (tid == 0) __hip_atomic_fetch_add((unsigned*)(p.ws + WS_BAR), 1u, __ATOMIC_RELAXED, __HIP_MEMORY_SCOPE_AGENT);
}

__device__ __forceinline__ void phase0(const Params& p, LAS unsigned char* lds) {
    const int tid = opaque_tid();
    {
        const int item = blockIdx.x;
        if (item < 96) p0_mod(p, lds, item);
        else if (item < 104) { const int hh = item - 96; p0_transpose(lds, p.in[9] + hh * 4096, 64, (bf16_t*)(p.ws + WS_WR) + hh * 4096, 64, 0, 0, 0); }
        else if (item < 112) { const int hh = item - 104; p0_transpose(lds, p.in[11] + hh * 4096, 64, (bf16_t*)(p.ws + WS_WI) + hh * 4096, 64, 0, 0, 0); }
        else if (item < 116) { const int g = item - 112; const float* sp = p.in[16] + g * 16384; bf16_t* d = (bf16_t*)(p.ws + WS_WSP) + g * 16384;
            for (int idx = tid; idx < 16384; idx += NTHR) { const int i = idx >> 7, j = idx & 127; d[idx] = ((j >> 6) <= (i >> 6)) ? f2bf(sp[idx]) : (bf16_t)0; } }
    }
    f32x4 va[4][2], vb[4][2];
    SuperItem ia = p0_item(p, blockIdx.x), ib = p0_item(p, blockIdx.x + 256), ic = p0_item(p, blockIdx.x + 512);
    p0_super_load(ia, tid, va);
    p0_super_load(ib, tid, vb);
    p0_super_store(lds, ia, tid, va);
    p0_super_load(ic, tid, va);
    p0_super_store(lds, ib, tid, vb);
    p0_super_store(lds, ic, tid, va);
}

__device__ __forceinline__ float ssq4(const f32x4& v) { return v[0] * v[0] + v[1] * v[1] + v[2] * v[2] + v[3] * v[3]; }
__device__ __forceinline__ void phase1(const Params& p) {
    const int tid = opaque_tid(), wid = tid >> 6, lane = tid & 63;
    const float* x = p.in[0]; const float* g = p.in[4]; const float* mod = (const float*)(p.ws + WS_MOD);
    bf16_t* h = (bf16_t*)(p.ws + WS_H);
    const int r0 = (blockIdx.x * 8 + wid) * 8, b = r0 >> 12;
    f32x4 v[8][4];
#pragma unroll
    for (int r = 0; r < 8; ++r)
#pragma unroll
        for (int e = 0; e < 4; ++e) v[r][e] = __builtin_nontemporal_load((const f32x4*)(x + (size_t)(r0 + r) * DM + 4 * (lane + 64 * e)));
    {
        if (wid == 0) {
            unsigned* cntp = (unsigned*)(p.ws + WS_BAR); unsigned sp = 0;
            while ((unsigned)__builtin_amdgcn_readfirstlane((int)__hip_atomic_load(cntp, __ATOMIC_RELAXED, __HIP_MEMORY_SCOPE_AGENT)) < 96u) { __builtin_amdgcn_s_sleep(8); if (++sp > (1u << 20)) break; }
            __builtin_amdgcn_fence(__ATOMIC_ACQUIRE, "agent");
        }
        asm volatile("s_waitcnt vmcnt(0)" ::: "memory");
        __syncthreads();
    }
    f32x4 gs[4], sh[4];
#pragma unroll
    for (int e = 0; e < 4; ++e) { const int k = 4 * (lane + 64 * e); gs[e] = *(const f32x4*)(g + k) * (1.0f + *(const f32x4*)(mod + b * UPC + 1024 + k)); sh[e] = *(const f32x4*)(mod + b * UPC + k); }
#pragma unroll
    for (int r = 0; r < 8; ++r) {
        const float ss = wave_sum(ssq4(v[r][0]) + ssq4(v[r][1]) + ssq4(v[r][2]) + ssq4(v[r][3]));
        const float rstd = rsqrtf(ss * (1.0f / DM) + EPS);
#pragma unroll
        for (int e = 0; e < 4; ++e) {
            const f32x4 o = v[r][e] * rstd * gs[e] + sh[e];
            u32x2 w; w.x = pk_bf16(o[0], o[1]); w.y = pk_bf16(o[2], o[3]);
            *(u32x2*)(h + (size_t)(r0 + r) * DM + 4 * (lane + 64 * e)) = w;
        }
    }
}

constexpr int VS = 514;
constexpr int SS = 516;
constexpr int XS = 520;
__device__ __forceinline__ void phase3(const Params& p, LAS unsigned char* lds) {
    const int tid = opaque_tid(), wid = tid >> 6, lane = tid & 63, fr = lane & 15, fq = lane >> 4;
    const int q = blockIdx.x, t0 = q * 64, hpar = q & 1, tb = t0 - 64 * hpar, nv = 64 * (hpar + 1);
    const bf16_t* z = (const bf16_t*)(p.ws + WS_Z);
    bf16_t* ycat = (bf16_t*)(p.ws + WS_YCAT);
    {
        LAS bf16_t* V = (LAS bf16_t*)lds;
        f32x2 vg[4], vb[4];
#pragma unroll
        for (int e = 0; e < 4; ++e) { vg[e] = *(const f32x2*)(p.in[14] + 2 * (lane + 64 * e)); vb[e] = *(const f32x2*)(p.in[15] + 2 * (lane + 64 * e)); }
        for (int j0 = wid; j0 < nv; j0 += 32) {
            float a[4][8];
#pragma unroll
            for (int r = 0; r < 4; ++r) {
                const bf16_t* zr = z + (size_t)(tb + j0 + 8 * r) * INC + 1536;
#pragma unroll
                for (int e = 0; e < 4; ++e) { const unsigned w = *(const unsigned*)(zr + 2 * (lane + 64 * e)); a[r][2 * e] = bflo(w); a[r][2 * e + 1] = bfhi(w); }
            }
#pragma unroll
            for (int r = 0; r < 4; ++r) {
                float sm = 0.f;
#pragma unroll
                for (int e = 0; e < 8; ++e) sm += a[r][e];
                const float mu = wave_sum(sm) * (1.0f / 512.0f); float qv = 0.f;
#pragma unroll
                for (int e = 0; e < 8; ++e) { a[r][e] -= mu; qv += a[r][e] * a[r][e]; }
                const float rstd = rsqrtf(wave_sum(qv) * (1.0f / 512.0f) + EPS);
#pragma unroll
                for (int e = 0; e < 4; ++e)
                    *(LAS unsigned*)(V + (j0 + 8 * r) * VS + 2 * (lane + 64 * e)) = pk_bf16(a[r][2 * e] * rstd * vg[e][0] + vb[e][0], a[r][2 * e + 1] * rstd * vg[e][1] + vb[e][1]);
            }
        }
    }
    __syncthreads();
    f32x4 sacc[4][4];
    const int grp = wid >> 1, cbase = grp * 128 + (wid & 1) * 64;
    {
        const LAS bf16_t* V = (const LAS bf16_t*)lds;
        const bf16_t* Wsp = (const bf16_t*)(p.ws + WS_WSP) + grp * 16384;
#pragma unroll
        for (int mt = 0; mt < 4; ++mt)
#pragma unroll
            for (int nt = 0; nt < 4; ++nt) sacc[mt][nt] = (f32x4){0.f, 0.f, 0.f, 0.f};
        const int nks = nv >> 5;
        for (int ks = 0; ks < nks; ++ks) {
            bf16x8 af[4], bfr[4];
#pragma unroll
            for (int mt = 0; mt < 4; ++mt) af[mt] = *(const bf16x8*)(Wsp + (hpar * 64 + mt * 16 + fr) * 128 + ks * 32 + fq * 8);
#pragma unroll
            for (int nt = 0; nt < 4; ++nt) {
#pragma unroll
                for (int e = 0; e < 8; ++e) bfr[nt][e] = (short)V[(ks * 32 + fq * 8 + e) * VS + cbase + nt * 16 + fr];
            }
#pragma unroll
            for (int mt = 0; mt < 4; ++mt)
#pragma unroll
                for (int nt = 0; nt < 4; ++nt) sacc[mt][nt] = __builtin_amdgcn_mfma_f32_16x16x32_bf16(af[mt], bfr[nt], sacc[mt][nt], 0, 0, 0);
        }
    }
    __syncthreads();
    {
        LAS float* S = (LAS float*)lds;
        const float* bsp = p.in[17] + grp * 128 + hpar * 64;
#pragma unroll
        for (int mt = 0; mt < 4; ++mt) {
            const f32x4 bv = *(const f32x4*)(bsp + mt * 16 + fq * 4);
#pragma unroll
            for (int nt = 0; nt < 4; ++nt)
#pragma unroll
                for (int jj = 0; jj < 4; ++jj) S[(mt * 16 + fq * 4 + jj) * SS + cbase + nt * 16 + fr] = sacc[mt][nt][jj] + bv[jj];
        }
    }
    __syncthreads();
    {
        const LAS float* S = (const LAS float*)lds;
        f32x2 go[4];
#pragma unroll
        for (int e = 0; e < 4; ++e) go[e] = *(const f32x2*)(p.in[19] + 2 * (lane + 64 * e));
        for (int i0 = wid; i0 < 64; i0 += 32) {
            unsigned uw[4][4];
#pragma unroll
            for (int r = 0; r < 4; ++r)
#pragma unroll
                for (int e = 0; e < 4; ++e) uw[r][e] = *(const unsigned*)(z + (size_t)(t0 + i0 + 8 * r) * INC + 1024 + 2 * (lane + 64 * e));
#pragma unroll
            for (int r = 0; r < 4; ++r) {
                const int i = i0 + 8 * r;
                float y[8]; float ss = 0.f;
#pragma unroll
                for (int e = 0; e < 4; ++e) {
                    const f32x2 sv = *(const LAS f32x2*)(S + i * SS + 2 * (lane + 64 * e));
                    y[2 * e] = bflo(uw[r][e]) * sv[0]; y[2 * e + 1] = bfhi(uw[r][e]) * sv[1]; ss += y[2 * e] * y[2 * e] + y[2 * e + 1] * y[2 * e + 1];
                }
                const float rstd = rsqrtf(wave_sum(ss) * (1.0f / 512.0f) + EPS);
#pragma unroll
                for (int e = 0; e < 4; ++e)
                    *(unsigned*)(ycat + (size_t)(t0 + i) * DM + 512 + 2 * (lane + 64 * e)) = pk_bf16(y[2 * e] * rstd * go[e][0], y[2 * e + 1] * rstd * go[e][1]);
            }
        }
    }
    __syncthreads();
    LAS bf16_t* XC = (LAS bf16_t*)lds;
    LAS _Float16* LA = (LAS _Float16*)(lds + 64 * XS * 2);
    {
        const int cp = tid & 255, th = tid >> 8, c0 = 2 * cp;
        const float* cwp = p.in[7];
        const f32x2 w0 = *(const f32x2*)(cwp + c0), w1 = *(const f32x2*)(cwp + 512 + c0), w2 = *(const f32x2*)(cwp + 1024 + c0), w3 = *(const f32x2*)(cwp + 1536 + c0), cbv = *(const f32x2*)(p.in[8] + c0);
        unsigned xw[35];
        const bool zero_halo = ((q & 63) == 0) && (th == 0);
#pragma unroll
        for (int tt = 0; tt < 35; ++tt) {
            const int tg = t0 + th * 32 + tt - 3;
            xw[tt] = (tt < 3 && zero_halo) ? 0u : *(const unsigned*)(z + (size_t)tg * INC + c0);
        }
#pragma unroll
        for (int t = 0; t < 32; ++t) {
            const float a = w0[0] * bflo(xw[t]) + w1[0] * bflo(xw[t + 1]) + w2[0] * bflo(xw[t + 2]) + w3[0] * bflo(xw[t + 3]) + cbv[0];
            const float b = w0[1] * bfhi(xw[t]) + w1[1] * bfhi(xw[t + 1]) + w2[1] * bfhi(xw[t + 2]) + w3[1] * bfhi(xw[t + 3]) + cbv[1];
            *(LAS unsigned*)(XC + (th * 32 + t) * XS + c0) = pk_bf16(a, b);
        }
    }
    __syncthreads();
    {
        const int hh = wid;
        bf16x8 af[4][2];
#pragma unroll
        for (int mt = 0; mt < 4; ++mt)
#pragma unroll
            for (int ks = 0; ks < 2; ++ks) af[mt][ks] = *(const LAS bf16x8*)(XC + (mt * 16 + fr) * XS + hh * 64 + ks * 32 + fq * 8);
        const bf16_t* WrT = (const bf16_t*)(p.ws + WS_WR) + hh * 4096;
        const bf16_t* WiT = (const bf16_t*)(p.ws + WS_WI) + hh * 4096;
        LAS _Float16* BX = (LAS _Float16*)lds;
#pragma unroll
        for (int nt = 0; nt < 4; ++nt) {
            const int ch = hh * 64 + nt * 16 + fr;
            bf16x8 br[2], bi[2];
#pragma unroll
            for (int ks = 0; ks < 2; ++ks) { br[ks] = *(const bf16x8*)(WrT + (nt * 16 + fr) * 64 + ks * 32 + fq * 8); bi[ks] = *(const bf16x8*)(WiT + (nt * 16 + fr) * 64 + ks * 32 + fq * 8); }
            const float brg = p.in[10][ch], big = p.in[12][ch];
            const float la_ = p.in[13][ch];
            const float spv = (la_ < -15.f) ? -la_ : __logf(1.0f + __expf(-la_));
#pragma unroll
            for (int mt = 0; mt < 4; ++mt) {
                f32x4 ar = {0.f, 0.f, 0.f, 0.f}, aiv = ar;
#pragma unroll
                for (int ks = 0; ks < 2; ++ks) { ar = __builtin_amdgcn_mfma_f32_16x16x32_bf16(af[mt][ks], br[ks], ar, 0, 0, 0); aiv = __builtin_amdgcn_mfma_f32_16x16x32_bf16(af[mt][ks], bi[ks], aiv, 0, 0, 0); }
#pragma unroll
                for (int jj = 0; jj < 4; ++jj) {
                    const int t = mt * 16 + fq * 4 + jj;
                    const float xcv = bf2f(XC[t * XS + ch]);
                    const float r = sigmoid_f(ar[jj] + brg), ig = sigmoid_f(aiv[jj] + big);
                    const float l2a = -11.541560327111707f * spv * r;
                    const float mult = __builtin_amdgcn_sqrtf(fmaxf(1.0f - __builtin_amdgcn_exp2f(2.0f * l2a), 0.f));
                    LA[t * XS + ch] = (_Float16)l2a;
                    BX[t * XS + ch] = (_Float16)(mult * ig * xcv);
                }
            }
        }
    }
    __syncthreads();
    {
        const LAS _Float16* BX = (const LAS _Float16*)lds;
        const int ch = tid;
        float hh = 0.f, sla = 0.f;
#pragma unroll 16
        for (int t = 0; t < 64; ++t) { const float l2 = (float)LA[t * XS + ch]; hh = __builtin_amdgcn_exp2f(l2) * hh + (float)BX[t * XS + ch]; sla += l2; }
        ((float*)(p.ws + WS_AGGA))[q * 512 + ch] = sla;
        ((float*)(p.ws + WS_AGGH))[q * 512 + ch] = hh;
    }
}

__device__ __forceinline__ void phase4(const Params& p, LAS unsigned char* lds) {
    const int tid = opaque_tid(), wid = tid >> 6, lane = tid & 63;
    const int q = blockIdx.x, t0 = q * 64;
    const bf16_t* z = (const bf16_t*)(p.ws + WS_Z);
    bf16_t* ycat = (bf16_t*)(p.ws + WS_YCAT);
    LAS _Float16* BX = (LAS _Float16*)lds;
    const LAS _Float16* LA = (const LAS _Float16*)(lds + 64 * XS * 2);
    {
        const int ch = tid;
        const float* aggA = (const float*)(p.ws + WS_AGGA); const float* aggH = (const float*)(p.ws + WS_AGGH);
        const int nprev = q & 63, base = q - nprev;
        float hh = 0.f;
        for (int k0 = 0; k0 < nprev; k0 += 16) {
            float A[16], H[16];
#pragma unroll
            for (int j = 0; j < 16; ++j) { const int kk = (k0 + j < nprev) ? (k0 + j) : (nprev - 1); A[j] = aggA[(base + kk) * 512 + ch]; H[j] = aggH[(base + kk) * 512 + ch]; }
#pragma unroll
            for (int j = 0; j < 16; ++j) if (k0 + j < nprev) hh = __builtin_amdgcn_exp2f(A[j]) * hh + H[j];
        }
#pragma unroll 16
        for (int t = 0; t < 64; ++t) {
            hh = __builtin_amdgcn_exp2f((float)LA[t * XS + ch]) * hh + (float)BX[t * XS + ch];
            BX[t * XS + ch] = (_Float16)hh;
        }
    }
    __syncthreads();
    {
        f32x2 go[4];
#pragma unroll
        for (int e = 0; e < 4; ++e) go[e] = *(const f32x2*)(p.in[18] + 2 * (lane + 64 * e));
        for (int i0 = wid; i0 < 64; i0 += 32) {
            unsigned gw[4][4];
#pragma unroll
            for (int r = 0; r < 4; ++r)
#pragma unroll
                for (int e = 0; e < 4; ++e) gw[r][e] = *(const unsigned*)(z + (size_t)(t0 + i0 + 8 * r) * INC + 512 + 2 * (lane + 64 * e));
#pragma unroll
            for (int r = 0; r < 4; ++r) {
                const int t = i0 + 8 * r;
                float y[8]; float ss = 0.f;
#pragma unroll
                for (int e = 0; e < 4; ++e) {
                    const h16x2 hv = *(const LAS h16x2*)(BX + t * XS + 2 * (lane + 64 * e));
                    y[2 * e] = (float)hv[0] * bflo(gw[r][e]); y[2 * e + 1] = (float)hv[1] * bfhi(gw[r][e]); ss += y[2 * e] * y[2 * e] + y[2 * e + 1] * y[2 * e + 1];
                }
                const float rstd = rsqrtf(wave_sum(ss) * (1.0f / 512.0f) + EPS);
#pragma unroll
                for (int e = 0; e < 4; ++e)
                    *(unsigned*)(ycat + (size_t)(t0 + t) * DM + 2 * (lane + 64 * e)) = pk_bf16(y[2 * e] * rstd * go[e][0], y[2 * e + 1] * rstd * go[e][1]);
            }
        }
    }
    __syncthreads();
}

__global__ void __launch_bounds__(NTHR) fwd_megakernel(Params p) {
    LAS unsigned char* lds = (LAS unsigned char*)smem;
    if ((threadIdx.x & 63) == 0) *(LAS int*)(lds + WTAB_OFF + 4 * hw_wave_slot()) = (int)(threadIdx.x >> 6);
    if (threadIdx.x < 4) ((LAS unsigned*)(lds + LDS_BYTES - 16))[threadIdx.x] = 0u;
    __syncthreads();
    const XcdBarrier bar = xcd_barrier_post((unsigned*)(p.ws + WS_BAR), (volatile LAS unsigned*)(lds + LDS_BYTES - 16));
#define GRID_SYNC() xcd_barrier(bar)

#define REPS(k) 1
    phase0(p, lds);
    __syncthreads();
    phase1(p);
    GRID_SYNC();
    int vcu;
    {
        unsigned* bw = (unsigned*)(p.ws + WS_BAR);
        unsigned pre = 0;
        for (unsigned j = 0; j < 16; ++j) { const unsigned c = xb_ld(&bw[XB_XCNT(j)]); pre += (j < bar.x) ? c : 0u; }
        const unsigned lin = pre + bar.st[2];
        vcu = (gridDim.x == 256 && lin < 256u) ? (int)((lin & 31u) * 8u + (lin >> 5)) : (int)blockIdx.x;
        vcu = __builtin_amdgcn_readfirstlane(vcu);
    }
    for (int r = 0; r < REPS(2); ++r) { EpiBf16 e{(bf16_t*)(p.ws + WS_Z), INC, 2}; gemm_phase(lds, (const bf16_t*)(p.ws + WS_H), (const bf16_t*)(p.ws + WS_WIN), MTOK, INC, DM, vcu, e); GRID_SYNC(); }
    for (int r = 0; r < REPS(3); ++r) { phase3(p, lds); GRID_SYNC(); }
    phase4(p, lds);
    GRID_SYNC();
    {
        const float* mod = (const float*)(p.ws + WS_MOD); float* xb = (float*)(p.ws + WS_XBUF); unsigned* cn = (unsigned*)(p.ws + WS_CNT);
        EpiMixOut e{p.in[0], (bf16_t*)(p.ws + WS_Y), (bf16_t*)(p.ws + WS_H), mod, p.in[5], p.in[21], RowX{xb, cn}, RowX{xb + (size_t)MTOK * 4, cn + 4096}};
        gemm_phase(lds, (const bf16_t*)(p.ws + WS_YCAT), (const bf16_t*)(p.ws + WS_WOUT), MTOK, DM, DM, vcu, e); GRID_SYNC();
    }
    for (int r = 0; r < REPS(7); ++r) { EpiUp e{(bf16_t*)(p.ws + WS_ACT), (float*)(p.ws + WS_HALO), p.in[24], p.in[25]}; gemm_phase(lds, (const bf16_t*)(p.ws + WS_H), (const bf16_t*)(p.ws + WS_WUP), MTOK, UPC, DM, vcu, e); GRID_SYNC(); }
    {
        EpiDownOut e{p.out, (const bf16_t*)(p.ws + WS_Y), (const float*)(p.ws + WS_MOD), p.in[22], RowX{(float*)(p.ws + WS_XBUF) + (size_t)MTOK * 8, (unsigned*)(p.ws + WS_CNT) + 8192}, (const float*)(p.ws + WS_HALO), p.in[24], p.in[25], (bf16_t*)(p.ws + WS_ACT)};
        gemm_phase(lds, (const bf16_t*)(p.ws + WS_ACT), (const bf16_t*)(p.ws + WS_WDOWN), MTOK, DM, DFF, vcu, e);
    }
}

extern "C" void kernel_launch(void* const* d_in, const int* in_sizes, int n_in, void* d_out, int out_size, void* d_ws, size_t ws_size, hipStream_t stream) {
    static int grid_blocks = 0;
    if (!grid_blocks) {
        int dev = 0, cus = 0, per_cu = 0;
        (void)hipGetDevice(&dev);
        (void)hipDeviceGetAttribute(&cus, hipDeviceAttributeMultiprocessorCount, dev);
        (void)hipFuncSetAttribute((const void*)fwd_megakernel, hipFuncAttributeMaxDynamicSharedMemorySize, LDS_BYTES);
        (void)hipOccupancyMaxActiveBlocksPerMultiprocessor(&per_cu, (const void*)fwd_megakernel, NTHR, LDS_BYTES);
        if (cus * per_cu < 256) fprintf(stderr, "resident capacity %d x %d < 256 blocks: the grid barrier cannot complete\n", cus, per_cu);
        grid_blocks = 256;
    }
    Params p{};
    for (int i = 0; i < 27; ++i) p.in[i] = (const float*)d_in[i];
    p.out = (float*)d_out; p.ws = (unsigned char*)d_ws;
    void* args[] = {&p};
    (void)hipMemsetAsync((unsigned char*)d_ws + WS_BAR, 0, WS_ZERO_BYTES, stream);
    hipError_t e = hipLaunchCooperativeKernel((const void*)fwd_megakernel, dim3(grid_blocks), dim3(NTHR), args, LDS_BYTES, stream);
    if (e != hipSuccess) fprintf(stderr, "cooperative launch failed: %s (grid %d)\n", hipGetErrorString(e), grid_blocks);
}
```

```cpp
#include <hip/hip_runtime.h>
#include <hip/hip_cooperative_groups.h>
#include <cstdio>
#include <cstdint>
namespace cg = cooperative_groups;

#define LAS __attribute__((address_space(3)))
typedef unsigned short bf16_t;
typedef short bf16x8 __attribute__((ext_vector_type(8)));
typedef float f32x4 __attribute__((ext_vector_type(4)));
typedef float f32x2 __attribute__((ext_vector_type(2)));
typedef unsigned u32x4 __attribute__((ext_vector_type(4)));
typedef unsigned u32x2 __attribute__((ext_vector_type(2)));

constexpr int DM = 1024, SEQ = 4096, MTOK = 16384;
constexpr int INC = 2048, DFF = 3072, UPC = 6144;
constexpr int NTHR = 512;
constexpr int LDS_BYTES = 144 * 1024;
constexpr float EPS = 1e-6f;

constexpr size_t MB = 1024 * 1024;
constexpr size_t WS_WIN = 0, WS_WOUT = 4 * MB, WS_WUP = 6 * MB, WS_WDOWN = 18 * MB;
constexpr size_t WS_WR = 24 * MB, WS_WI = 24 * MB + 65536, WS_WSP = 24 * MB + 131072, WS_MOD = 24 * MB + 262144;
constexpr size_t WS_AGGA = 24 * MB + 393216, WS_AGGH = 24 * MB + 917504, WS_BAR = 24 * MB + 1441792, WS_CNT = WS_BAR + 16384  , WS_ZERO_BYTES = 65536;
constexpr size_t WS_XBUF = 192 * MB;
constexpr size_t WS_HALO = 26 * MB, WS_H = 32 * MB, WS_Y = 64 * MB, WS_Z = 96 * MB, WS_YCAT = 160 * MB, WS_ACT = 96 * MB;

struct Params { const float* in[27]; float* out; unsigned char* ws; };

__device__ __forceinline__ unsigned pk_bf16(float lo, float hi) { unsigned r; asm("v_cvt_pk_bf16_f32 %0, %1, %2" : "=v"(r) : "v"(lo), "v"(hi)); return r; }
__device__ __forceinline__ bf16_t f2bf(float f) { return (bf16_t)(pk_bf16(f, 0.f) & 0xffffu); }
__device__ __forceinline__ float bf2f(unsigned b) { return __uint_as_float(b << 16); }
__device__ __forceinline__ float bflo(unsigned w) { return __uint_as_float(w << 16); }
__device__ __forceinline__ float bfhi(unsigned w) { return __uint_as_float(w & 0xffff0000u); }
extern __shared__ __attribute__((aligned(16))) unsigned char smem[];
constexpr int WTAB_OFF = LDS_BYTES - 16 - 256;
__device__ __forceinline__ int hw_wave_slot() { return (int)(__builtin_amdgcn_s_getreg((5 << 11) | 4) & 63u); }
__device__ __forceinline__ int opaque_tid() {
    int w = *(const volatile LAS int*)((LAS unsigned char*)smem + WTAB_OFF + 4 * hw_wave_slot());
    int t = __builtin_amdgcn_readfirstlane(w) * 64 + (int)__builtin_amdgcn_mbcnt_hi(~0u, __builtin_amdgcn_mbcnt_lo(~0u, 0u));
    asm volatile("" : "+v"(t)); return t;
}
template <int CTRL> __device__ __forceinline__ float dpp_mov(float v) { return __int_as_float(__builtin_amdgcn_update_dpp(0, __float_as_int(v), CTRL, 0xf, 0xf, true)); }
__device__ __forceinline__ float wave_sum(float v) {
    v += dpp_mov<0xB1>(v); v += dpp_mov<0x4E>(v); v += dpp_mov<0x141>(v); v += dpp_mov<0x140>(v);
    const int iv = __float_as_int(v);
    return (__int_as_float(__builtin_amdgcn_readlane(iv, 0)) + __int_as_float(__builtin_amdgcn_readlane(iv, 16))) +
           (__int_as_float(__builtin_amdgcn_readlane(iv, 32)) + __int_as_float(__builtin_amdgcn_readlane(iv, 48)));
}
typedef _Float16 h16x2 __attribute__((ext_vector_type(2)));
__device__ __forceinline__ float gelu_t(float x) {
    const float u = 0.7978845608028654f * (x + 0.044715f * x * x * x);
    const float e = __builtin_amdgcn_exp2f(-2.885390081777927f * u);
    return x * __builtin_amdgcn_rcpf(1.0f + e);
}
__device__ __forceinline__ f32x2 gelu2(f32x2 x) {
    const f32x2 t = x * x;
    const f32x2 a = x * (t * (-2.885390081777927f * 0.7978845608028654f * 0.044715f) + (-2.885390081777927f * 0.7978845608028654f));
    f32x2 e; e.x = __builtin_amdgcn_exp2f(a.x); e.y = __builtin_amdgcn_exp2f(a.y);
    const f32x2 d = e + 1.0f;
    f32x2 r; r.x = __builtin_amdgcn_rcpf(d.x); r.y = __builtin_amdgcn_rcpf(d.y);
    return x * r;
}
__device__ __forceinline__ float sigmoid_f(float x) { return __builtin_amdgcn_rcpf(1.0f + __builtin_amdgcn_exp2f(-1.4426950408889634f * x)); }


#define XB_TMO      128
#define XB_XCNT(j)  (256  + 64 * (j))
#define XB_XSUB(j)  (1280 + 64 * (j))
#define XB_XGEN(j)  (2304 + 64 * (j))
#define XB_TOP      3328
#define XB_TOPGEN   3392
#define XCD_BAR_WORDS 3456
#define XB_SPIN_CAP (1u << 20)
__device__ __forceinline__ unsigned xb_ld(unsigned* p)              { return __hip_atomic_load(p, __ATOMIC_RELAXED, __HIP_MEMORY_SCOPE_AGENT); }
__device__ __forceinline__ unsigned xb_add(unsigned* p, unsigned v) { return __hip_atomic_fetch_add(p, v, __ATOMIC_RELAXED, __HIP_MEMORY_SCOPE_AGENT); }
__device__ __forceinline__ unsigned xb_xcc_id() { return (unsigned)__builtin_amdgcn_s_getreg((3 << 11) | 20) & 0xFu; }
#define XB_SPIN(cond, bar) do { unsigned _sp = 0; while (cond) { __builtin_amdgcn_s_sleep(1); \
    if ((++_sp & 255u) == 0u) { if (xb_ld(&(bar)[XB_TMO])) break; if (_sp > XB_SPIN_CAP) { atomicAdd(&(bar)[XB_TMO], 1u); break; } } } } while (0)
struct XcdBarrier { unsigned* bar; unsigned x; volatile LAS unsigned* st; };
__device__ __forceinline__ XcdBarrier xcd_barrier_post(unsigned* bar, volatile LAS unsigned* st) {
    XcdBarrier b; b.bar = bar; b.x = xb_xcc_id(); b.st = st;
    if (threadIdx.x == 0) st[2] = xb_add(&bar[XB_XCNT(b.x)], 1u);
    return b;
}
__device__ __forceinline__ void xcd_barrier_complete(unsigned* bar, unsigned x, unsigned& nloc, unsigned& nx) {
    const unsigned G = gridDim.x * gridDim.y * gridDim.z;
    unsigned sum, cnt, mine, sp = 0u;
    for (;;) {
        sum = 0u; cnt = 0u; mine = 0u;
#pragma unroll
        for (unsigned j = 0; j < 16; ++j) { const unsigned c = xb_ld(&bar[XB_XCNT(j)]); sum += c; cnt += (c > 0u) ? 1u : 0u; mine = (j == x) ? c : mine; }
        if (sum == G) break;
        __builtin_amdgcn_s_sleep(1);
        if ((++sp & 255u) == 0u) { if (xb_ld(&bar[XB_TMO])) break; if (sp > XB_SPIN_CAP) { atomicAdd(&bar[XB_TMO], 1u); break; } }
    }
    nloc = mine > 0u ? mine : 1u; nx = cnt > 0u ? cnt : 1u;
}
__device__ __forceinline__ void xcd_barrier(const XcdBarrier& b) {
    asm volatile("s_waitcnt vmcnt(0)" ::: "memory");
    __syncthreads();
    if (opaque_tid() == 0) {
        unsigned* bar = b.bar;
        __builtin_amdgcn_s_waitcnt(0);
        unsigned nloc = b.st[0], nx = b.st[1];
        if (nloc == 0u) { xcd_barrier_complete(bar, b.x, nloc, nx); b.st[0] = nloc; b.st[1] = nx; }
        const unsigned old = xb_add(&bar[XB_XSUB(b.x)], 1u);
        const unsigned gen = old / nloc;
        if (old + 1u == (gen + 1u) * nloc) {
            __builtin_amdgcn_fence(__ATOMIC_RELEASE, "agent");
            asm volatile("s_waitcnt vmcnt(0)" ::: "memory");
            const unsigned og = xb_add(&bar[XB_TOP], 1u);
            const unsigned tg = og / nx;
            if (og + 1u == (tg + 1u) * nx) xb_add(&bar[XB_TOPGEN], 1u);
            else XB_SPIN(xb_ld(&bar[XB_TOPGEN]) == tg, bar);
            __builtin_amdgcn_fence(__ATOMIC_ACQUIRE, "agent");
            xb_add(&bar[XB_XGEN(b.x)], 1u);
            asm volatile("s_waitcnt vmcnt(0)" ::: "memory");
        } else {
            XB_SPIN(xb_ld(&bar[XB_XGEN(b.x)]) == gen, bar);
            __builtin_amdgcn_fence(__ATOMIC_ACQUIRE, "agent");
            asm volatile("s_waitcnt vmcnt(0)" ::: "memory");
        }
    }
    __syncthreads();
}

constexpr int HTB = 16384;
__device__ __forceinline__ int lds_byte(int r, int c) { const int st = (r >> 4) * 2 + (c >> 5), rr = r & 15, cc = c & 31, ob = rr * 64 + cc * 2; return st * 1024 + (ob ^ (((ob >> 9) & 1) << 5)); }
__device__ __forceinline__ void stage_rc(int b, int& R, int& C) { const int st = b / 1024, sb = b % 1024, swz = sb ^ (((sb >> 9) & 1) << 5); R = (st >> 1) * 16 + swz / 64; C = (st & 1) * 32 + (swz % 64) / 2; }

struct UnitOrder {
    int nM, nN, nwg, G, c;
    __device__ __forceinline__ void init(int M, int N, int G_, int c_) { nM = M >> 8; nN = N >> 8; nwg = nM * nN; G = G_; c = c_; }
    __device__ __forceinline__ bool next(int i, int& pm, int& pn) const {
        const long L = (long)i * G + c; if (L >= nwg) return false;
        int wgid = (int)L; { const int q = nwg / 8, r = nwg % 8, xcd = wgid % 8, off = wgid / 8; wgid = (xcd < r ? xcd * (q + 1) : r * (q + 1) + (xcd - r) * q) + off; }
        const int nig = 8 * nN, gid = wgid / nig, fm = gid * 8, gsz = (nM - fm) < 8 ? (nM - fm) : 8;
        pm = fm + ((wgid % nig) % gsz); pn = (wgid % nig) / gsz; return true;
    }
};
template <class Epi>
__device__ __forceinline__ void gemm_phase(LAS unsigned char* lds, const bf16_t* __restrict__ A, const bf16_t* __restrict__ Bt, const int M, const int N, const int K, const int vcu, const Epi& epi) {
    const int tid = opaque_tid(), wid = __builtin_amdgcn_readfirstlane(tid >> 6), lane = tid & 63, wr = wid >> 2, wc = wid & 3, fr = lane & 15, fq = lane >> 4;
    const int nt = K / 64;
    unsigned voffB[2], voffA[2];
#pragma unroll
    for (int i = 0; i < 2; ++i) { int r, c; stage_rc(tid * 16 + i * 8192, r, c); const int rb = (r & ~31) + 8 * ((r & 15) >> 2) + 4 * ((r >> 4) & 1) + (r & 3); voffB[i] = (unsigned)(rb * K + c) * 2u; const int ra = Epi::PERMA ? ((r & 64) | ((r & 15) << 2) | ((r >> 4) & 3)) : r; voffA[i] = (unsigned)(ra * K + c) * 2u; }
    const size_t kstep = 128, hstep = (size_t)128 * K * 2, tstep = 2 * hstep;
    const unsigned ldsbase = (unsigned)__builtin_amdgcn_readfirstlane((int)(unsigned)(unsigned long)lds) + (unsigned)wid * 1024u;
    const int aoff = lds_byte(wr * 64 + fr, fq * 8), boff = lds_byte(wc * 32 + fr, fq * 8);
#define SA(b, h) (((b) * 2 + (h)) * HTB)
#define SB(b, h) ((4 + (b) * 2 + (h)) * HTB)
#define STAGE(bufoff, gbase, VO) do { const char* _g = (gbase); const unsigned _m0 = ldsbase + (unsigned)(bufoff); unsigned _keep; \
    asm volatile("s_mov_b32 %0, m0\n\ts_mov_b32 m0, %3\n\ts_nop 0\n\tglobal_load_lds_dwordx4 %1, %2\n\ts_add_u32 m0, m0, 0x2000\n\ts_nop 0\n\tglobal_load_lds_dwordx4 %4, %2\n\ts_mov_b32 m0, %0" \
                 : "=&s"(_keep) : "v"(VO[0]), "s"(_g), "s"(_m0), "v"(VO[1]) : "memory"); } while (0)
#define LDA(dst, b, h) do { _Pragma("unroll") for (int m = 0; m < 4; ++m) _Pragma("unroll") for (int k = 0; k < 2; ++k) dst[m][k] = *(const LAS bf16x8*)(lds + SA(b, h) + aoff + m * 2048 + k * 1024); } while (0)
#define LDB(dst, b, h) do { _Pragma("unroll") for (int n = 0; n < 2; ++n) _Pragma("unroll") for (int k = 0; k < 2; ++k) dst[n][k] = *(const LAS bf16x8*)(lds + SB(b, h) + boff + n * 2048 + k * 1024); } while (0)
#define MMA(ai, bj, At_, Bt_) do { __builtin_amdgcn_s_setprio(1); \
    _Pragma("unroll") for (int m = 0; m < 4; ++m) _Pragma("unroll") for (int n = 0; n < 2; ++n) _Pragma("unroll") for (int k = 0; k < 2; ++k) \
      acc[ai][bj][m][n] = __builtin_amdgcn_mfma_f32_16x16x32_bf16(Bt_[n][k], At_[m][k], acc[ai][bj][m][n], 0, 0, 0); \
    __builtin_amdgcn_s_setprio(0); } while (0)
#define WAIT_V(n) asm volatile("s_waitcnt vmcnt(" #n ")" ::: "memory")
#define WAIT_L(n) asm volatile("s_waitcnt lgkmcnt(" #n ")" ::: "memory")
#define BAR __builtin_amdgcn_s_barrier()
#define SCHED __builtin_amdgcn_sched_barrier(0)
#define ZERO_ACC() do { _Pragma("unroll") for (int a = 0; a < 2; ++a) _Pragma("unroll") for (int b = 0; b < 2; ++b) _Pragma("unroll") for (int m = 0; m < 4; ++m) _Pragma("unroll") for (int n = 0; n < 2; ++n) acc[a][b][m][n] = (f32x4){0.f, 0.f, 0.f, 0.f}; } while (0)
    UnitOrder S; S.init(M, N, (int)gridDim.x, vcu);
    int cpm, cpn, npm = 0, npn = 0, ui = 0;
    if (!S.next(0, cpm, cpn)) return;
    epi.prefetch(cpn, lds);
    WAIT_V(0); WAIT_L(0); __syncthreads();
    f32x4 acc[2][2][4][2];
    ZERO_ACC();
    bf16x8 At[4][2], B0[2][2], B1[2][2];
    const char* cA = (const char*)A + (size_t)cpm * tstep; const char* cB = (const char*)Bt + (size_t)cpn * tstep;
    STAGE(SB(0, 0), cB, voffB); STAGE(SB(0, 1), cB + hstep, voffB); STAGE(SA(0, 0), cA, voffA); STAGE(SA(0, 1), cA + hstep, voffA);
    if (wr == 1) BAR;
    WAIT_V(2); BAR;
    STAGE(SB(1, 0), cB + kstep, voffB); STAGE(SA(1, 0), cA + kstep, voffA); STAGE(SB(1, 1), cB + hstep + kstep, voffB);
    WAIT_V(6); BAR;
    for (;;) {
        const bool has_next = S.next(ui + 1, npm, npn);
        const char* nA = has_next ? (const char*)A + (size_t)npm * tstep : cA; const char* nB = has_next ? (const char*)Bt + (size_t)npn * tstep : cB;
        for (int t = 0; t < nt; t += 2) {
            const bool last = (t == nt - 2);
            const char* a1 = cA + (size_t)(t + 1) * kstep;
            const char* a2 = last ? nA : cA + (size_t)(t + 2) * kstep; const char* b2 = last ? nB : cB + (size_t)(t + 2) * kstep;
            const char* a3 = a2 + kstep; const char* b3 = b2 + kstep;
            LDB(B0, 0, 0); LDB(B1, 0, 1); SCHED; LDA(At, 0, 0); STAGE(SA(1, 1), a1 + hstep, voffA);
            WAIT_V(8); WAIT_L(0); BAR; MMA(0, 0, At, B0); MMA(0, 1, At, B1); BAR; SCHED;
            LDA(At, 0, 1); STAGE(SB(0, 0), b2, voffB); STAGE(SB(0, 1), b2 + hstep, voffB); STAGE(SA(0, 0), a2, voffA);
            WAIT_V(8); WAIT_L(0); BAR; MMA(1, 0, At, B0); MMA(1, 1, At, B1); BAR; SCHED;
            LDB(B0, 1, 0); LDB(B1, 1, 1); SCHED; LDA(At, 1, 0); STAGE(SA(0, 1), a2 + hstep, voffA);
            WAIT_V(8); WAIT_L(0); BAR; MMA(0, 0, At, B0); MMA(0, 1, At, B1); BAR; SCHED;
            LDA(At, 1, 1); STAGE(SB(1, 0), b3, voffB); STAGE(SB(1, 1), b3 + hstep, voffB); STAGE(SA(1, 0), a3, voffA);
            WAIT_V(8); WAIT_L(0); BAR; MMA(1, 0, At, B0); MMA(1, 1, At, B1); BAR; SCHED;
        }
        if (Epi::ALIGN) { if (wr == 0) BAR; }
        if (!Epi::AFTER_DRAIN) epi(acc, cpm, cpn, has_next ? npn : -1, lds);
        if (!has_next) break;
        ZERO_ACC();
        cpm = npm; cpn = npn; cA = nA; cB = nB; ++ui;
        if (Epi::ALIGN) { if (wr == 1) BAR; }
    }
    WAIT_V(0);
    if (!Epi::ALIGN) { if (wr == 0) BAR; }
    BAR;
    if (Epi::AFTER_DRAIN) epi(acc, cpm, cpn, -1, lds);
    WAIT_V(0); WAIT_L(0); __syncthreads();
#undef SA
#undef SB
#undef STAGE
#undef LDA
#undef LDB
#undef MMA
#undef ZERO_ACC
}

struct EpiBf16 {
    static constexpr bool PERMA = false, AFTER_DRAIN = false, ALIGN = false;
    bf16_t* O; int ldc; int gelu_from;
    __device__ __forceinline__ void prefetch(int, LAS unsigned char*) const {}
    __device__ __forceinline__ void operator()(f32x4 (&acc)[2][2][4][2], int pm, int pn, int, LAS unsigned char*) const {
        const int tid = opaque_tid(), wid = tid >> 6, lane = tid & 63, wr = wid >> 2, wc = wid & 3, fr = lane & 15, fq = lane >> 4;
        const bool g = pn >= gelu_from;
#pragma unroll
        for (int ai = 0; ai < 2; ++ai)
#pragma unroll
            for (int m = 0; m < 4; ++m) {
                bf16_t* rowp = O + (size_t)(pm * 256 + ai * 128 + wr * 64 + m * 16 + fr) * ldc + pn * 256 + wc * 32 + 8 * fq;
#pragma unroll
                for (int bj = 0; bj < 2; ++bj) {
                    f32x4 v0 = acc[ai][bj][m][0], v1 = acc[ai][bj][m][1];
                    if (g) { const f32x2 a = gelu2((f32x2){v0[0], v0[1]}), b = gelu2((f32x2){v0[2], v0[3]}), c = gelu2((f32x2){v1[0], v1[1]}), d = gelu2((f32x2){v1[2], v1[3]});
                             v0 = (f32x4){a.x, a.y, b.x, b.y}; v1 = (f32x4){c.x, c.y, d.x, d.y}; }
                    u32x4 w; w.x = pk_bf16(v0[0], v0[1]); w.y = pk_bf16(v0[2], v0[3]); w.z = pk_bf16(v1[0], v1[1]); w.w = pk_bf16(v1[2], v1[3]);
                    *(u32x4*)(rowp + bj * 128) = w;
                }
            }
    }
};

#define DPP_SHR1 0x111
constexpr int CWL_OFF = 131072;
constexpr int HB_OFF = 135168;
struct EpiUp {
    static constexpr bool PERMA = true, AFTER_DRAIN = false, ALIGN = true;
    bf16_t* act; float* halo; const float* cw; const float* cb;
    __device__ __forceinline__ void prefetch(int pn, LAS unsigned char* lds) const {
        const int t = opaque_tid();
        if (t < 256) {
            const int arr = t >> 6, c4 = (t & 63) * 4, oc = (c4 >> 7) * 3072 + pn * 128 + (c4 & 127);
            const f32x4 v = *(const f32x4*)((arr < 3 ? cw + arr * UPC : cb) + oc);
            *(LAS f32x4*)(lds + CWL_OFF + (arr * 256 + c4) * 4) = v;
        }
    }
    __device__ __forceinline__ void operator()(f32x4 (&acc)[2][2][4][2], int pm, int pn, int nxt_pn, LAS unsigned char* lds) const {
        const int tid = opaque_tid(), wid = tid >> 6, lane = tid & 63, wr = wid >> 2, wc = wid & 3, fr = lane & 15, fq = lane >> 4;
        LAS float* Hb = (LAS float*)(lds + HB_OFF);
        f32x4 nxt_cw = (f32x4){0.f, 0.f, 0.f, 0.f};
        if (nxt_pn >= 0 && tid < 256) { const int arr = tid >> 6, c4 = (tid & 63) * 4, oc = (c4 >> 7) * 3072 + nxt_pn * 128 + (c4 & 127); nxt_cw = *(const f32x4*)((arr < 3 ? cw + arr * UPC : cb) + oc); }
        const int tc = wc * 32 + 8 * fq;
        if (fr == 15) {
#pragma unroll
            for (int ai = 0; ai < 2; ++ai)
#pragma unroll
                for (int bj = 0; bj < 2; ++bj)
#pragma unroll
                    for (int n = 0; n < 2; ++n) {
                        *(LAS f32x4*)(Hb + ((ai * 2 + wr) * 2 + 0) * 256 + bj * 128 + n * 4 + tc) = acc[ai][bj][2][n];
                        *(LAS f32x4*)(Hb + ((ai * 2 + wr) * 2 + 1) * 256 + bj * 128 + n * 4 + tc) = acc[ai][bj][3][n];
                    }
        }
        {
            float* hg = halo + (size_t)pm * 4 * UPC + (size_t)pn * 256 + tc;
            if (wr == 0 && fr == 0) {
#pragma unroll
                for (int bj = 0; bj < 2; ++bj)
#pragma unroll
                    for (int n = 0; n < 2; ++n) { *(f32x4*)(hg + bj * 128 + n * 4) = acc[0][bj][0][n]; *(f32x4*)(hg + UPC + bj * 128 + n * 4) = acc[0][bj][1][n]; }
            }
            if (wr == 1 && fr == 15) {
#pragma unroll
                for (int bj = 0; bj < 2; ++bj)
#pragma unroll
                    for (int n = 0; n < 2; ++n) { *(f32x4*)(hg + 2 * UPC + bj * 128 + n * 4) = acc[1][bj][2][n]; *(f32x4*)(hg + 3 * UPC + bj * 128 + n * 4) = acc[1][bj][3][n]; }
            }
        }
        __syncthreads();
#pragma unroll
        for (int ai = 0; ai < 2; ++ai) {
            const int s = ai * 2 + wr;
            u32x2 wq[2][4];
#pragma unroll
            for (int n = 0; n < 2; ++n) {
                f32x4 res[2][4];
#pragma unroll
                for (int bj = 0; bj < 2; ++bj) {
                    const LAS float* cwl = (const LAS float*)(lds + CWL_OFF) + bj * 128 + n * 4 + tc;
                    const f32x4 w0 = *(const LAS f32x4*)cwl, w1 = *(const LAS f32x4*)(cwl + 256), w2 = *(const LAS f32x4*)(cwl + 512), bb = *(const LAS f32x4*)(cwl + 768);
                    f32x4 h2 = (f32x4){0.f, 0.f, 0.f, 0.f}, h3 = h2;
                    if (s > 0 && fr == 0) { h2 = *(const LAS f32x4*)(Hb + ((s - 1) * 2 + 0) * 256 + bj * 128 + n * 4 + tc); h3 = *(const LAS f32x4*)(Hb + ((s - 1) * 2 + 1) * 256 + bj * 128 + n * 4 + tc); }
                    const f32x4 x0 = acc[ai][bj][0][n], x1 = acc[ai][bj][1][n], x2 = acc[ai][bj][2][n], x3 = acc[ai][bj][3][n];
                    f32x4 p2, p3;
#pragma unroll
                    for (int e = 0; e < 4; ++e) {
                        p2[e] = __int_as_float(__builtin_amdgcn_update_dpp(__float_as_int(h2[e]), __float_as_int(x2[e]), DPP_SHR1, 0xf, 0xf, false));
                        p3[e] = __int_as_float(__builtin_amdgcn_update_dpp(__float_as_int(h3[e]), __float_as_int(x3[e]), DPP_SHR1, 0xf, 0xf, false));
                    }
                    res[bj][0] = w2 * x0 + w1 * p3 + w0 * p2 + bb;
                    res[bj][1] = w2 * x1 + w1 * x0 + w0 * p3 + bb;
                    res[bj][2] = w2 * x2 + w1 * x1 + w0 * x0 + bb;
                    res[bj][3] = w2 * x3 + w1 * x2 + w0 * x1 + bb;
                }
#pragma unroll
                for (int m = 0; m < 4; ++m) {
                    const f32x4 g = res[0][m], v = res[1][m];
                    const f32x2 lo = gelu2((f32x2){g[0], g[1]}) * (f32x2){v[0], v[1]}, hi = gelu2((f32x2){g[2], g[3]}) * (f32x2){v[2], v[3]};
                    wq[n][m].x = pk_bf16(lo.x, lo.y); wq[n][m].y = pk_bf16(hi.x, hi.y);
                }
            }
#pragma unroll
            for (int m = 0; m < 4; ++m) {
                u32x4 w; w.x = wq[0][m].x; w.y = wq[0][m].y; w.z = wq[1][m].x; w.w = wq[1][m].y;
                *(u32x4*)(act + (size_t)(pm * 256 + ai * 128 + wr * 64 + 4 * fr + m) * DFF + pn * 128 + tc) = w;
            }
        }
        __syncthreads();
        if (nxt_pn >= 0 && tid < 256) *(LAS f32x4*)(lds + CWL_OFF + ((tid >> 6) * 256 + (tid & 63) * 4) * 4) = nxt_cw;
    }
};

struct RowX { float* xbuf; unsigned* cnt; };
__device__ __forceinline__ void row_exchange(float (&part)[2][4], float (&rstd)[2][4], const RowX& X, int pm, int pn, LAS unsigned char* lds, int tid) {
    const int wid = tid >> 6, lane = tid & 63, wr = wid >> 2, wc = wid & 3, fr = lane & 15, fq = lane >> 4;
    LAS float* P = (LAS float*)lds;
    LAS float* S = (LAS float*)(lds + 4096);
#pragma unroll
    for (int ai = 0; ai < 2; ++ai)
#pragma unroll
        for (int m = 0; m < 4; ++m) {
            float v = part[ai][m];
            v += __shfl_xor(v, 16); v += __shfl_xor(v, 32);
            if (fq == 0) P[(ai * 128 + wr * 64 + m * 16 + fr) * 4 + wc] = v;
        }
    asm volatile("s_waitcnt lgkmcnt(0)" ::: "memory"); __syncthreads();
    if (tid < 256) {
        const f32x4 a = *(const LAS f32x4*)(P + tid * 4);
        __hip_atomic_store(X.xbuf + ((size_t)pm * 256 + tid) * 4 + pn, (a[0] + a[1]) + (a[2] + a[3]), __ATOMIC_RELAXED, __HIP_MEMORY_SCOPE_AGENT);
    }
    asm volatile("s_waitcnt vmcnt(0)" ::: "memory");
    if (lane == 0 && wid < 4) __hip_atomic_fetch_add(X.cnt + 64 * pm, 1u, __ATOMIC_RELAXED, __HIP_MEMORY_SCOPE_AGENT);
    if (wid == 0) {
        unsigned sp = 0;
        while ((unsigned)__builtin_amdgcn_readfirstlane((int)__hip_atomic_load(X.cnt + 64 * pm, __ATOMIC_RELAXED, __HIP_MEMORY_SCOPE_AGENT)) < 16u) { __builtin_amdgcn_s_sleep(4); if (++sp > (1u << 20)) break; }
    }
    asm volatile("s_waitcnt vmcnt(0) lgkmcnt(0)" ::: "memory"); __syncthreads();
    if (tid < 256) {
        const float* sl = X.xbuf + ((size_t)pm * 256 + tid) * 4;
        const float t = (__hip_atomic_load(sl, __ATOMIC_RELAXED, __HIP_MEMORY_SCOPE_AGENT) + __hip_atomic_load(sl + 1, __ATOMIC_RELAXED, __HIP_MEMORY_SCOPE_AGENT)) +
                        (__hip_atomic_load(sl + 2, __ATOMIC_RELAXED, __HIP_MEMORY_SCOPE_AGENT) + __hip_atomic_load(sl + 3, __ATOMIC_RELAXED, __HIP_MEMORY_SCOPE_AGENT));
        S[tid] = rsqrtf(t * (1.0f / DM) + EPS);
    }
    asm volatile("s_waitcnt lgkmcnt(0)" ::: "memory"); __syncthreads();
#pragma unroll
    for (int ai = 0; ai < 2; ++ai)
#pragma unroll
        for (int m = 0; m < 4; ++m) rstd[ai][m] = S[ai * 128 + wr * 64 + m * 16 + fr];
}
__device__ __forceinline__ f32x4 unpack4(const u32x2 w) { return (f32x4){bflo(w.x), bfhi(w.x), bflo(w.y), bfhi(w.y)}; }
__device__ __forceinline__ float ssq4v(const f32x4& v) { return v[0] * v[0] + v[1] * v[1] + v[2] * v[2] + v[3] * v[3]; }

struct EpiMixOut {
    static constexpr bool PERMA = false, AFTER_DRAIN = true, ALIGN = false;
    const float* x; bf16_t* x1b; bf16_t* h; const float* mod; const float* gpost; const float* gpre; RowX X1, X2;
    __device__ __forceinline__ void prefetch(int, LAS unsigned char*) const {}
    __device__ __forceinline__ void operator()(f32x4 (&acc)[2][2][4][2], int pm, int pn, int, LAS unsigned char* lds) const {
        const int tid = opaque_tid(), wid = tid >> 6, lane = tid & 63, wr = wid >> 2, wc = wid & 3, fr = lane & 15, fq = lane >> 4;
        const int b = pm >> 4;
        float part[2][4], rs[2][4];
#pragma unroll
        for (int ai = 0; ai < 2; ++ai)
#pragma unroll
            for (int m = 0; m < 4; ++m) part[ai][m] = (ssq4v(acc[ai][0][m][0]) + ssq4v(acc[ai][0][m][1])) + (ssq4v(acc[ai][1][m][0]) + ssq4v(acc[ai][1][m][1]));
        const int col0 = pn * 256 + wc * 32 + 8 * fq;
        {
            f32x4 xv[4][2][2];
#pragma unroll
            for (int m = 0; m < 4; ++m) {
                const float* xr = (const float*)((const char*)x + (unsigned)((pm * 256 + wr * 64 + m * 16 + fr) * DM + col0) * 4u);
#pragma unroll
                for (int bj = 0; bj < 2; ++bj)
#pragma unroll
                    for (int n = 0; n < 2; ++n) xv[m][bj][n] = __builtin_nontemporal_load((const f32x4*)(xr + bj * 128 + n * 4));
            }
            row_exchange(part, rs, X1, pm, pn, lds, tid);
            f32x4 gp[2][2];
#pragma unroll
            for (int bj = 0; bj < 2; ++bj)
#pragma unroll
                for (int n = 0; n < 2; ++n) gp[bj][n] = *(const f32x4*)(gpost + col0 + bj * 128 + n * 4) * *(const f32x4*)(mod + b * UPC + 2048 + col0 + bj * 128 + n * 4);
#pragma unroll
            for (int ai = 0; ai < 2; ++ai)
#pragma unroll
                for (int m = 0; m < 4; ++m) {
                    const unsigned ro = (unsigned)((pm * 256 + ai * 128 + wr * 64 + m * 16 + fr) * DM + col0) * 4u;
                    bf16_t* orow = (bf16_t*)((char*)x1b + (ro >> 1));
#pragma unroll
                    for (int bj = 0; bj < 2; ++bj) {
                        u32x4 w;
#pragma unroll
                        for (int n = 0; n < 2; ++n) {
                            const f32x4 o = xv[m][bj][n] + gp[bj][n] * (acc[ai][bj][m][n] * rs[ai][m]);
                            acc[ai][bj][m][n] = o;
                            if (n == 0) { w.x = pk_bf16(o[0], o[1]); w.y = pk_bf16(o[2], o[3]); } else { w.z = pk_bf16(o[0], o[1]); w.w = pk_bf16(o[2], o[3]); }
                        }
                        *(u32x4*)(orow + bj * 128) = w;
                    }
                    if (ai == 0) {
                        const float* xr = (const float*)((const char*)x + ro + 128u * DM * 4u);
#pragma unroll
                        for (int bj = 0; bj < 2; ++bj)
#pragma unroll
                            for (int n = 0; n < 2; ++n) xv[m][bj][n] = __builtin_nontemporal_load((const f32x4*)(xr + bj * 128 + n * 4));
                    }
                    __builtin_amdgcn_sched_barrier(0);
                }
        }
#pragma unroll
        for (int ai = 0; ai < 2; ++ai)
#pragma unroll
            for (int m = 0; m < 4; ++m) part[ai][m] = (ssq4v(acc[ai][0][m][0]) + ssq4v(acc[ai][0][m][1])) + (ssq4v(acc[ai][1][m][0]) + ssq4v(acc[ai][1][m][1]));
        row_exchange(part, rs, X2, pm, pn, lds, tid);
        {
            f32x4 gs[2][2], sh[2][2];
#pragma unroll
            for (int bj = 0; bj < 2; ++bj)
#pragma unroll
                for (int n = 0; n < 2; ++n) {
                    const int col = col0 + bj * 128 + n * 4;
                    gs[bj][n] = *(const f32x4*)(gpre + col) * (1.0f + *(const f32x4*)(mod + b * UPC + 4096 + col)); sh[bj][n] = *(const f32x4*)(mod + b * UPC + 3072 + col);
                }
#pragma unroll
            for (int ai = 0; ai < 2; ++ai)
#pragma unroll
                for (int m = 0; m < 4; ++m) {
                    const unsigned ro = (unsigned)((pm * 256 + ai * 128 + wr * 64 + m * 16 + fr) * DM + col0) * 2u;
                    bf16_t* hr = (bf16_t*)((char*)h + ro);
#pragma unroll
                    for (int bj = 0; bj < 2; ++bj) {
                        const f32x4 o0 = acc[ai][bj][m][0] * rs[ai][m] * gs[bj][0] + sh[bj][0], o1 = acc[ai][bj][m][1] * rs[ai][m] * gs[bj][1] + sh[bj][1];
                        u32x4 w; w.x = pk_bf16(o0[0], o0[1]); w.y = pk_bf16(o0[2], o0[3]); w.z = pk_bf16(o1[0], o1[1]); w.w = pk_bf16(o1[2], o1[3]);
                        *(u32x4*)(hr + bj * 128) = w;
                    }
                    __builtin_amdgcn_sched_barrier(0);
                }
        }
        __syncthreads();
    }
};

struct EpiDownOut {
    static constexpr bool PERMA = false, AFTER_DRAIN = true, ALIGN = false;
    float* out; const bf16_t* x1b; const float* mod; const float* gpost; RowX X;
    __device__ __forceinline__ void prefetch(int, LAS unsigned char*) const {}
    __device__ __forceinline__ void operator()(f32x4 (&acc)[2][2][4][2], int pm, int pn, int, LAS unsigned char* lds) const {
        const int tid = opaque_tid(), wid = tid >> 6, lane = tid & 63, wr = wid >> 2, wc = wid & 3, fr = lane & 15, fq = lane >> 4;
        const int b = pm >> 4;
        float part[2][4], rs[2][4];
#pragma unroll
        for (int ai = 0; ai < 2; ++ai)
#pragma unroll
            for (int m = 0; m < 4; ++m) part[ai][m] = (ssq4v(acc[ai][0][m][0]) + ssq4v(acc[ai][0][m][1])) + (ssq4v(acc[ai][1][m][0]) + ssq4v(acc[ai][1][m][1]));
        const int col0 = pn * 256 + wc * 32 + 8 * fq;
        u32x2 xv[4][2][2];
#pragma unroll
        for (int r = 0; r < 4; ++r) {
            const bf16_t* xr = (const bf16_t*)((const char*)x1b + (unsigned)((pm * 256 + wr * 64 + r * 16 + fr) * DM + col0) * 2u);
#pragma unroll
            for (int bj = 0; bj < 2; ++bj)
#pragma unroll
                for (int n = 0; n < 2; ++n) xv[r][bj][n] = *(const u32x2*)(xr + bj * 128 + n * 4);
        }
        row_exchange(part, rs, X, pm, pn, lds, tid);
        f32x4 gp[2][2];
#pragma unroll
        for (int bj = 0; bj < 2; ++bj)
#pragma unroll
            for (int n = 0; n < 2; ++n) gp[bj][n] = *(const f32x4*)(gpost + col0 + bj * 128 + n * 4) * *(const f32x4*)(mod + b * UPC + 5120 + col0 + bj * 128 + n * 4);
#pragma unroll
        for (int r = 0; r < 8; ++r) {
            const int ai = r >> 2, m = r & 3;
            const unsigned ro = (unsigned)((pm * 256 + ai * 128 + wr * 64 + m * 16 + fr) * DM + col0) * 4u;
            float* orow = (float*)((char*)out + ro);
#pragma unroll
            for (int bj = 0; bj < 2; ++bj)
#pragma unroll
                for (int n = 0; n < 2; ++n) *(f32x4*)(orow + bj * 128 + n * 4) = unpack4(xv[r & 3][bj][n]) + gp[bj][n] * (acc[ai][bj][m][n] * rs[ai][m]);
            if (r + 4 < 8) {
                const bf16_t* xr = (const bf16_t*)((const char*)x1b + (unsigned)((pm * 256 + 128 + wr * 64 + m * 16 + fr) * DM + col0) * 2u);
#pragma unroll
                for (int bj = 0; bj < 2; ++bj)
#pragma unroll
                    for (int n = 0; n < 2; ++n) xv[r & 3][bj][n] = *(const u32x2*)(xr + bj * 128 + n * 4);
            }
            __builtin_amdgcn_sched_barrier(0);
        }
        __syncthreads();
    }
};

__device__ __forceinline__ void p0_transpose(LAS unsigned char* lds, const float* __restrict__ src, int ldn, bf16_t* __restrict__ dst, int ldk, int k0, int n0, int dstrow0) {
    LAS bf16_t* T = (LAS bf16_t*)lds;
    const int tid = opaque_tid();
    {
        const int k = tid >> 3, n8 = (tid & 7) * 8;
        const float* sp = src + (size_t)(k0 + k) * ldn + n0 + n8;
        const f32x4 v0 = *(const f32x4*)sp, v1 = *(const f32x4*)(sp + 4);
#pragma unroll
        for (int e = 0; e < 4; ++e) { T[(n8 + e) * 72 + k] = f2bf(v0[e]); T[(n8 + 4 + e) * 72 + k] = f2bf(v1[e]); }
    }
    __syncthreads();
    {
        const int n = tid >> 3, k8 = (tid & 7) * 8;
        const u32x4 o = *(const LAS u32x4*)(T + n * 72 + k8);
        *(u32x4*)(dst + (size_t)(dstrow0 + n) * ldk + k0 + k8) = o;
    }
    __syncthreads();
}
struct SuperItem { const float* src; bf16_t* dst; int ldn, ldk, k0, n0, up; };
__device__ __forceinline__ SuperItem p0_item(const Params& p, int idx) {
    SuperItem it;
    if (idx < 128)      { it.src = p.in[6];  it.dst = (bf16_t*)(p.ws + WS_WIN);   it.ldn = INC; it.ldk = DM;  it.k0 = (idx >> 3) * 64; it.n0 = (idx & 7) * 256; it.up = 0; }
    else if (idx < 192) { const int i = idx - 128; it.src = p.in[20]; it.dst = (bf16_t*)(p.ws + WS_WOUT);  it.ldn = DM;  it.ldk = DM;  it.k0 = (i >> 2) * 64; it.n0 = (i & 3) * 256; it.up = 0; }
    else if (idx < 576) { const int i = idx - 192; it.src = p.in[23]; it.dst = (bf16_t*)(p.ws + WS_WUP);   it.ldn = UPC; it.ldk = DM;  it.k0 = (i / 24) * 64; it.n0 = (i % 24) * 256; it.up = 1; }
    else                { const int i = idx - 576; it.src = p.in[26]; it.dst = (bf16_t*)(p.ws + WS_WDOWN); it.ldn = DM;  it.ldk = DFF; it.k0 = (i >> 2) * 64; it.n0 = (i & 3) * 256; it.up = 0; }
    return it;
}
__device__ __forceinline__ void p0_super_load(const SuperItem& it, int tid, f32x4 (&v)[4][2]) {
    const int k = tid >> 3, n8 = (tid & 7) * 8;
    const float* sp = it.src + (size_t)(it.k0 + k) * it.ldn + it.n0 + n8;
#pragma unroll
    for (int sb = 0; sb < 4; ++sb) { v[sb][0] = __builtin_nontemporal_load((const f32x4*)(sp + sb * 64)); v[sb][1] = __builtin_nontemporal_load((const f32x4*)(sp + sb * 64 + 4)); }
}
__device__ __forceinline__ void p0_super_store(LAS unsigned char* lds, const SuperItem& it, int tid, const f32x4 (&v)[4][2]) {
    LAS bf16_t* T = (LAS bf16_t*)lds;
    {
        const int k = tid >> 3, n8 = (tid & 7) * 8;
#pragma unroll
        for (int sb = 0; sb < 4; ++sb)
#pragma unroll
            for (int e = 0; e < 4; ++e) { T[sb * 4608 + (n8 + e) * 72 + k] = f2bf(v[sb][0][e]); T[sb * 4608 + (n8 + 4 + e) * 72 + k] = f2bf(v[sb][1][e]); }
    }
    __syncthreads();
    {
        const int n = tid >> 3, k8 = (tid & 7) * 8;
#pragma unroll
        for (int sb = 0; sb < 4; ++sb) {
            const int nn = it.n0 + sb * 64;
            int drow = nn;
            if (it.up) { const int half = nn / 3072, rem = nn % 3072; drow = (rem >> 7) * 256 + half * 128 + (rem & 127); }
            const u32x4 o = *(const LAS u32x4*)(T + sb * 4608 + n * 72 + k8);
            *(u32x4*)(it.dst + (size_t)(drow + n) * it.ldk + it.k0 + k8) = o;
        }
    }
    __syncthreads();
}

__device__ __forceinline__ void p0_mod(const Params& p, LAS unsigned char* lds, int item) {
    LAS float* sc = (LAS float*)lds; LAS float* red = (LAS float*)(lds + 16384);
    const int tid = opaque_tid();
    const float* c = p.in[1];
    for (int i = tid; i < 4096; i += NTHR) { const float v = c[i]; sc[i] = v * sigmoid_f(v); }
    __syncthreads();
    const int c4 = tid & 15, kr = tid >> 4, col = item * 64 + c4 * 4;
    const float* w = p.in[2];
    f32x4 a0 = {0.f, 0.f, 0.f, 0.f}, a1 = a0, a2 = a0, a3 = a0;
#pragma unroll 16
    for (int k = kr; k < 1024; k += 32) {
        const f32x4 wv = __builtin_nontemporal_load((const f32x4*)(w + (size_t)k * UPC + col));
        a0 += sc[k] * wv; a1 += sc[1024 + k] * wv; a2 += sc[2048 + k] * wv; a3 += sc[3072 + k] * wv;
    }
    *(LAS f32x4*)(red + (kr * 4 + 0) * 64 + c4 * 4) = a0; *(LAS f32x4*)(red + (kr * 4 + 1) * 64 + c4 * 4) = a1;
    *(LAS f32x4*)(red + (kr * 4 + 2) * 64 + c4 * 4) = a2; *(LAS f32x4*)(red + (kr * 4 + 3) * 64 + c4 * 4) = a3;
    __syncthreads();
    if (tid < 256) {
        const int b = tid >> 6, cc = tid & 63; float s = 0.f;
#pragma unroll 8
        for (int k2 = 0; k2 < 32; ++k2) s += red[(k2 * 4 + b) * 64 + cc];
        __hip_atomic_store((float*)(p.ws + WS_MOD) + b * UPC + item * 64 + cc, s + p.in[3][item * 64 + cc], __ATOMIC_RELAXED, __HIP_MEMORY_SCOPE_AGENT);
    }
    asm volatile("s_waitcnt vmcnt(0)" ::: "memory");
    __syncthreads();
    if (tid == 0) __hip_atomic_fetch_add((unsigned*)(p.ws + WS_BAR), 1u, __ATOMIC_RELAXED, __HIP_MEMORY_SCOPE_AGENT);
}

__device__ __forceinline__ void phase0(const Params& p, LAS unsigned char* lds, f32x4 (&xrow)[8][4]) {
    const int tid = opaque_tid();
    {
        const int item = blockIdx.x;
        if (item < 96) p0_mod(p, lds, item);
        else if (item < 104) { const int hh = item - 96; p0_transpose(lds, p.in[9] + hh * 4096, 64, (bf16_t*)(p.ws + WS_WR) + hh * 4096, 64, 0, 0, 0); }
        else if (item < 112) { const int hh = item - 104; p0_transpose(lds, p.in[11] + hh * 4096, 64, (bf16_t*)(p.ws + WS_WI) + hh * 4096, 64, 0, 0, 0); }
        else if (item < 116) { const int g = item - 112; const float* sp = p.in[16] + g * 16384; bf16_t* d = (bf16_t*)(p.ws + WS_WSP) + g * 16384;
            for (int idx = tid; idx < 16384; idx += NTHR) { const int i = idx >> 7, j = idx & 127; d[idx] = ((j >> 6) <= (i >> 6)) ? f2bf(sp[idx]) : (bf16_t)0; } }
    }
    f32x4 va[4][2], vb[4][2];
    SuperItem ia = p0_item(p, blockIdx.x), ib = p0_item(p, blockIdx.x + 256), ic = p0_item(p, blockIdx.x + 512);
    p0_super_load(ia, tid, va);
    p0_super_load(ib, tid, vb);
    {
        const int lane = tid & 63, r0 = (blockIdx.x * 8 + (tid >> 6)) * 8;
#pragma unroll
        for (int r = 0; r < 8; ++r)
#pragma unroll
            for (int e = 0; e < 4; ++e) xrow[r][e] = __builtin_nontemporal_load((const f32x4*)(p.in[0] + (size_t)(r0 + r) * DM + 4 * (lane + 64 * e)));
    }
    p0_super_store(lds, ia, tid, va);
    p0_super_load(ic, tid, va);
    p0_super_store(lds, ib, tid, vb);
    p0_super_store(lds, ic, tid, va);
}

__device__ __forceinline__ float ssq4(const f32x4& v) { return v[0] * v[0] + v[1] * v[1] + v[2] * v[2] + v[3] * v[3]; }
__device__ __forceinline__ void phase1(const Params& p, f32x4 (&v)[8][4]) {
    const int tid = opaque_tid(), wid = tid >> 6, lane = tid & 63;
    const float* x = p.in[0]; const float* g = p.in[4]; const float* mod = (const float*)(p.ws + WS_MOD);
    bf16_t* h = (bf16_t*)(p.ws + WS_H);
    const int r0 = (blockIdx.x * 8 + wid) * 8, b = r0 >> 12;
    {
        if (wid == 0) {
            unsigned* cntp = (unsigned*)(p.ws + WS_BAR); unsigned sp = 0;
            while ((unsigned)__builtin_amdgcn_readfirstlane((int)__hip_atomic_load(cntp, __ATOMIC_RELAXED, __HIP_MEMORY_SCOPE_AGENT)) < 96u) { __builtin_amdgcn_s_sleep(8); if (++sp > (1u << 20)) break; }
            __builtin_amdgcn_fence(__ATOMIC_ACQUIRE, "agent");
        }
        asm volatile("s_waitcnt vmcnt(0)" ::: "memory");
        __syncthreads();
    }
    f32x4 gs[4], sh[4];
#pragma unroll
    for (int e = 0; e < 4; ++e) { const int k = 4 * (lane + 64 * e); gs[e] = *(const f32x4*)(g + k) * (1.0f + *(const f32x4*)(mod + b * UPC + 1024 + k)); sh[e] = *(const f32x4*)(mod + b * UPC + k); }
#pragma unroll
    for (int r = 0; r < 8; ++r) {
        const float ss = wave_sum(ssq4(v[r][0]) + ssq4(v[r][1]) + ssq4(v[r][2]) + ssq4(v[r][3]));
        const float rstd = rsqrtf(ss * (1.0f / DM) + EPS);
#pragma unroll
        for (int e = 0; e < 4; ++e) {
            const f32x4 o = v[r][e] * rstd * gs[e] + sh[e];
            u32x2 w; w.x = pk_bf16(o[0], o[1]); w.y = pk_bf16(o[2], o[3]);
            *(u32x2*)(h + (size_t)(r0 + r) * DM + 4 * (lane + 64 * e)) = w;
        }
    }
}

constexpr int VS = 514;
constexpr int SS = 516;
constexpr int XS = 520;
__device__ __forceinline__ void phase3(const Params& p, LAS unsigned char* lds) {
    const int tid = opaque_tid(), wid = tid >> 6, lane = tid & 63, fr = lane & 15, fq = lane >> 4;
    const int q = blockIdx.x, t0 = q * 64, hpar = q & 1, tb = t0 - 64 * hpar, nv = 64 * (hpar + 1);
    const bf16_t* z = (const bf16_t*)(p.ws + WS_Z);
    bf16_t* ycat = (bf16_t*)(p.ws + WS_YCAT);
    {
        LAS bf16_t* V = (LAS bf16_t*)lds;
        f32x2 vg[4], vb[4];
#pragma unroll
        for (int e = 0; e < 4; ++e) { vg[e] = *(const f32x2*)(p.in[14] + 2 * (lane + 64 * e)); vb[e] = *(const f32x2*)(p.in[15] + 2 * (lane + 64 * e)); }
        for (int j0 = wid; j0 < nv; j0 += 32) {
            float a[4][8];
#pragma unroll
            for (int r = 0; r < 4; ++r) {
                const bf16_t* zr = z + (size_t)(tb + j0 + 8 * r) * INC + 1536;
#pragma unroll
                for (int e = 0; e < 4; ++e) { const unsigned w = *(const unsigned*)(zr + 2 * (lane + 64 * e)); a[r][2 * e] = bflo(w); a[r][2 * e + 1] = bfhi(w); }
            }
#pragma unroll
            for (int r = 0; r < 4; ++r) {
                float sm = 0.f;
#pragma unroll
                for (int e = 0; e < 8; ++e) sm += a[r][e];
                const float mu = wave_sum(sm) * (1.0f / 512.0f); float qv = 0.f;
#pragma unroll
                for (int e = 0; e < 8; ++e) { a[r][e] -= mu; qv += a[r][e] * a[r][e]; }
                const float rstd = rsqrtf(wave_sum(qv) * (1.0f / 512.0f) + EPS);
#pragma unroll
                for (int e = 0; e < 4; ++e)
                    *(LAS unsigned*)(V + (j0 + 8 * r) * VS + 2 * (lane + 64 * e)) = pk_bf16(a[r][2 * e] * rstd * vg[e][0] + vb[e][0], a[r][2 * e + 1] * rstd * vg[e][1] + vb[e][1]);
            }
        }
    }
    __syncthreads();
    f32x4 sacc[4][4];
    const int grp = wid >> 1, cbase = grp * 128 + (wid & 1) * 64;
    {
        const LAS bf16_t* V = (const LAS bf16_t*)lds;
        const bf16_t* Wsp = (const bf16_t*)(p.ws + WS_WSP) + grp * 16384;
#pragma unroll
        for (int mt = 0; mt < 4; ++mt)
#pragma unroll
            for (int nt = 0; nt < 4; ++nt) sacc[mt][nt] = (f32x4){0.f, 0.f, 0.f, 0.f};
        const int nks = nv >> 5;
        for (int ks = 0; ks < nks; ++ks) {
            bf16x8 af[4], bfr[4];
#pragma unroll
            for (int mt = 0; mt < 4; ++mt) af[mt] = *(const bf16x8*)(Wsp + (hpar * 64 + mt * 16 + fr) * 128 + ks * 32 + fq * 8);
#pragma unroll
            for (int nt = 0; nt < 4; ++nt) {
#pragma unroll
                for (int e = 0; e < 8; ++e) bfr[nt][e] = (short)V[(ks * 32 + fq * 8 + e) * VS + cbase + nt * 16 + fr];
            }
#pragma unroll
            for (int mt = 0; mt < 4; ++mt)
#pragma unroll
                for (int nt = 0; nt < 4; ++nt) sacc[mt][nt] = __builtin_amdgcn_mfma_f32_16x16x32_bf16(af[mt], bfr[nt], sacc[mt][nt], 0, 0, 0);
        }
    }
    __syncthreads();
    {
        LAS float* S = (LAS float*)lds;
        const float* bsp = p.in[17] + grp * 128 + hpar * 64;
#pragma unroll
        for (int mt = 0; mt < 4; ++mt) {
            const f32x4 bv = *(const f32x4*)(bsp + mt * 16 + fq * 4);
#pragma unroll
            for (int nt = 0; nt < 4; ++nt)
#pragma unroll
                for (int jj = 0; jj < 4; ++jj) S[(mt * 16 + fq * 4 + jj) * SS + cbase + nt * 16 + fr] = sacc[mt][nt][jj] + bv[jj];
        }
    }
    __syncthreads();
    {
        const LAS float* S = (const LAS float*)lds;
        f32x2 go[4];
#pragma unroll
        for (int e = 0; e < 4; ++e) go[e] = *(const f32x2*)(p.in[19] + 2 * (lane + 64 * e));
        for (int i0 = wid; i0 < 64; i0 += 32) {
            unsigned uw[4][4];
#pragma unroll
            for (int r = 0; r < 4; ++r)
#pragma unroll
                for (int e = 0; e < 4; ++e) uw[r][e] = *(const unsigned*)(z + (size_t)(t0 + i0 + 8 * r) * INC + 1024 + 2 * (lane + 64 * e));
#pragma unroll
            for (int r = 0; r < 4; ++r) {
                const int i = i0 + 8 * r;
                float y[8]; float ss = 0.f;
#pragma unroll
                for (int e = 0; e < 4; ++e) {
                    const f32x2 sv = *(const LAS f32x2*)(S + i * SS + 2 * (lane + 64 * e));
                    y[2 * e] = bflo(uw[r][e]) * sv[0]; y[2 * e + 1] = bfhi(uw[r][e]) * sv[1]; ss += y[2 * e] * y[2 * e] + y[2 * e + 1] * y[2 * e + 1];
                }
                const float rstd = rsqrtf(wave_sum(ss) * (1.0f / 512.0f) + EPS);
#pragma unroll
                for (int e = 0; e < 4; ++e)
                    *(unsigned*)(ycat + (size_t)(t0 + i) * DM + 512 + 2 * (lane + 64 * e)) = pk_bf16(y[2 * e] * rstd * go[e][0], y[2 * e + 1] * rstd * go[e][1]);
            }
        }
    }
    __syncthreads();
    LAS bf16_t* XC = (LAS bf16_t*)lds;
    LAS _Float16* LA = (LAS _Float16*)(lds + 64 * XS * 2);
    {
        const int cp = tid & 255, th = tid >> 8, c0 = 2 * cp;
        const float* cwp = p.in[7];
        const f32x2 w0 = *(const f32x2*)(cwp + c0), w1 = *(const f32x2*)(cwp + 512 + c0), w2 = *(const f32x2*)(cwp + 1024 + c0), w3 = *(const f32x2*)(cwp + 1536 + c0), cbv = *(const f32x2*)(p.in[8] + c0);
        unsigned xw[35];
        const bool zero_halo = ((q & 63) == 0) && (th == 0);
#pragma unroll
        for (int tt = 0; tt < 35; ++tt) {
            const int tg = t0 + th * 32 + tt - 3;
            xw[tt] = (tt < 3 && zero_halo) ? 0u : *(const unsigned*)(z + (size_t)tg * INC + c0);
        }
#pragma unroll
        for (int t = 0; t < 32; ++t) {
            const float a = w0[0] * bflo(xw[t]) + w1[0] * bflo(xw[t + 1]) + w2[0] * bflo(xw[t + 2]) + w3[0] * bflo(xw[t + 3]) + cbv[0];
            const float b = w0[1] * bfhi(xw[t]) + w1[1] * bfhi(xw[t + 1]) + w2[1] * bfhi(xw[t + 2]) + w3[1] * bfhi(xw[t + 3]) + cbv[1];
            *(LAS unsigned*)(XC + (th * 32 + t) * XS + c0) = pk_bf16(a, b);
        }
    }
    __syncthreads();
    {
        const int hh = wid;
        bf16x8 af[4][2];
#pragma unroll
        for (int mt = 0; mt < 4; ++mt)
#pragma unroll
            for (int ks = 0; ks < 2; ++ks) af[mt][ks] = *(const LAS bf16x8*)(XC + (mt * 16 + fr) * XS + hh * 64 + ks * 32 + fq * 8);
        const bf16_t* WrT = (const bf16_t*)(p.ws + WS_WR) + hh * 4096;
        const bf16_t* WiT = (const bf16_t*)(p.ws + WS_WI) + hh * 4096;
        LAS _Float16* BX = (LAS _Float16*)lds;
#pragma unroll
        for (int nt = 0; nt < 4; ++nt) {
            const int ch = hh * 64 + nt * 16 + fr;
            bf16x8 br[2], bi[2];
#pragma unroll
            for (int ks = 0; ks < 2; ++ks) { br[ks] = *(const bf16x8*)(WrT + (nt * 16 + fr) * 64 + ks * 32 + fq * 8); bi[ks] = *(const bf16x8*)(WiT + (nt * 16 + fr) * 64 + ks * 32 + fq * 8); }
            const float brg = p.in[10][ch], big = p.in[12][ch];
            const float la_ = p.in[13][ch];
            const float spv = (la_ < -15.f) ? -la_ : __logf(1.0f + __expf(-la_));
#pragma unroll
            for (int mt = 0; mt < 4; ++mt) {
                f32x4 ar = {0.f, 0.f, 0.f, 0.f}, aiv = ar;
#pragma unroll
                for (int ks = 0; ks < 2; ++ks) { ar = __builtin_amdgcn_mfma_f32_16x16x32_bf16(af[mt][ks], br[ks], ar, 0, 0, 0); aiv = __builtin_amdgcn_mfma_f32_16x16x32_bf16(af[mt][ks], bi[ks], aiv, 0, 0, 0); }
#pragma unroll
                for (int jj = 0; jj < 4; ++jj) {
                    const int t = mt * 16 + fq * 4 + jj;
                    const float xcv = bf2f(XC[t * XS + ch]);
                    const float r = sigmoid_f(ar[jj] + brg), ig = sigmoid_f(aiv[jj] + big);
                    const float l2a = -11.541560327111707f * spv * r;
                    const float mult = __builtin_amdgcn_sqrtf(fmaxf(1.0f - __builtin_amdgcn_exp2f(2.0f * l2a), 0.f));
                    LA[t * XS + ch] = (_Float16)l2a;
                    BX[t * XS + ch] = (_Float16)(mult * ig * xcv);
                }
            }
        }
    }
    __syncthreads();
    {
        const LAS _Float16* BX = (const LAS _Float16*)lds;
        const int ch = tid;
        float hh = 0.f, sla = 0.f;
#pragma unroll 16
        for (int t = 0; t < 64; ++t) { const float l2 = (float)LA[t * XS + ch]; hh = __builtin_amdgcn_exp2f(l2) * hh + (float)BX[t * XS + ch]; sla += l2; }
        ((float*)(p.ws + WS_AGGA))[q * 512 + ch] = sla;
        ((float*)(p.ws + WS_AGGH))[q * 512 + ch] = hh;
    }
}

__device__ __forceinline__ void phase4(const Params& p, LAS unsigned char* lds) {
    const int tid = opaque_tid(), wid = tid >> 6, lane = tid & 63;
    const int q = blockIdx.x, t0 = q * 64;
    const bf16_t* z = (const bf16_t*)(p.ws + WS_Z);
    bf16_t* ycat = (bf16_t*)(p.ws + WS_YCAT);
    LAS _Float16* BX = (LAS _Float16*)lds;
    const LAS _Float16* LA = (const LAS _Float16*)(lds + 64 * XS * 2);
    {
        const int ch = tid;
        const float* aggA = (const float*)(p.ws + WS_AGGA); const float* aggH = (const float*)(p.ws + WS_AGGH);
        const int nprev = q & 63, base = q - nprev;
        float hh = 0.f;
        for (int k0 = 0; k0 < nprev; k0 += 16) {
            float A[16], H[16];
#pragma unroll
            for (int j = 0; j < 16; ++j) { const int kk = (k0 + j < nprev) ? (k0 + j) : (nprev - 1); A[j] = aggA[(base + kk) * 512 + ch]; H[j] = aggH[(base + kk) * 512 + ch]; }
#pragma unroll
            for (int j = 0; j < 16; ++j) if (k0 + j < nprev) hh = __builtin_amdgcn_exp2f(A[j]) * hh + H[j];
        }
#pragma unroll 16
        for (int t = 0; t < 64; ++t) {
            hh = __builtin_amdgcn_exp2f((float)LA[t * XS + ch]) * hh + (float)BX[t * XS + ch];
            BX[t * XS + ch] = (_Float16)hh;
        }
    }
    __syncthreads();
    {
        f32x2 go[4];
#pragma unroll
        for (int e = 0; e < 4; ++e) go[e] = *(const f32x2*)(p.in[18] + 2 * (lane + 64 * e));
        for (int i0 = wid; i0 < 64; i0 += 32) {
            unsigned gw[4][4];
#pragma unroll
            for (int r = 0; r < 4; ++r)
#pragma unroll
                for (int e = 0; e < 4; ++e) gw[r][e] = *(const unsigned*)(z + (size_t)(t0 + i0 + 8 * r) * INC + 512 + 2 * (lane + 64 * e));
#pragma unroll
            for (int r = 0; r < 4; ++r) {
                const int t = i0 + 8 * r;
                float y[8]; float ss = 0.f;
#pragma unroll
                for (int e = 0; e < 4; ++e) {
                    const h16x2 hv = *(const LAS h16x2*)(BX + t * XS + 2 * (lane + 64 * e));
                    y[2 * e] = (float)hv[0] * bflo(gw[r][e]); y[2 * e + 1] = (float)hv[1] * bfhi(gw[r][e]); ss += y[2 * e] * y[2 * e] + y[2 * e + 1] * y[2 * e + 1];
                }
                const float rstd = rsqrtf(wave_sum(ss) * (1.0f / 512.0f) + EPS);
#pragma unroll
                for (int e = 0; e < 4; ++e)
                    *(unsigned*)(ycat + (size_t)(t0 + t) * DM + 2 * (lane + 64 * e)) = pk_bf16(y[2 * e] * rstd * go[e][0], y[2 * e + 1] * rstd * go[e][1]);
            }
        }
    }
    __syncthreads();
}

__device__ __forceinline__ void fixup_tile(const Params& p, int pm) {
    if ((pm & 15) == 0) return;
    const float* halo = (const float*)(p.ws + WS_HALO);
    const float* cw = p.in[24]; const float* cb = p.in[25];
    bf16_t* act = (bf16_t*)(p.ws + WS_ACT);
    const float* hp = halo + (size_t)(pm - 1) * 4 * UPC; const float* hc = halo + (size_t)pm * 4 * UPC;
    for (int i = opaque_tid(); i < DFF / 4; i += NTHR) {
        const int c4 = i * 4, gi = (c4 >> 7) * 256 + (c4 & 127);
        f32x4 r0[2], r1[2];
#pragma unroll
        for (int hv = 0; hv < 2; ++hv) {
            const int ti = gi + hv * 128, oc = hv * 3072 + c4;
            const f32x4 um2 = *(const f32x4*)(hp + 2 * UPC + ti), um1 = *(const f32x4*)(hp + 3 * UPC + ti), u0 = *(const f32x4*)(hc + ti), u1 = *(const f32x4*)(hc + UPC + ti);
            const f32x4 w0 = *(const f32x4*)(cw + oc), w1 = *(const f32x4*)(cw + UPC + oc), w2 = *(const f32x4*)(cw + 2 * UPC + oc), bb = *(const f32x4*)(cb + oc);
            r0[hv] = w0 * um2 + w1 * um1 + w2 * u0 + bb;
            r1[hv] = w0 * um1 + w1 * u0 + w2 * u1 + bb;
        }
        u32x2 a, b;
        a.x = pk_bf16(gelu_t(r0[0][0]) * r0[1][0], gelu_t(r0[0][1]) * r0[1][1]); a.y = pk_bf16(gelu_t(r0[0][2]) * r0[1][2], gelu_t(r0[0][3]) * r0[1][3]);
        b.x = pk_bf16(gelu_t(r1[0][0]) * r1[1][0], gelu_t(r1[0][1]) * r1[1][1]); b.y = pk_bf16(gelu_t(r1[0][2]) * r1[1][2], gelu_t(r1[0][3]) * r1[1][3]);
        *(u32x2*)(act + (size_t)(pm * 256) * DFF + c4) = a;
        *(u32x2*)(act + (size_t)(pm * 256 + 1) * DFF + c4) = b;
    }
}

__global__ void __launch_bounds__(NTHR) fwd_megakernel(Params p) {
    LAS unsigned char* lds = (LAS unsigned char*)smem;
    if ((threadIdx.x & 63) == 0) *(LAS int*)(lds + WTAB_OFF + 4 * hw_wave_slot()) = (int)(threadIdx.x >> 6);
    if (threadIdx.x < 4) ((LAS unsigned*)(lds + LDS_BYTES - 16))[threadIdx.x] = 0u;
    __syncthreads();
    const XcdBarrier bar = xcd_barrier_post((unsigned*)(p.ws + WS_BAR), (volatile LAS unsigned*)(lds + LDS_BYTES - 16));
#define GRID_SYNC() xcd_barrier(bar)

#define REPS(k) 1
    {
        f32x4 xrow[8][4];
        phase0(p, lds, xrow);
        __syncthreads();
        phase1(p, xrow);
    }
    GRID_SYNC();
    int vcu;
    {
        unsigned* bw = (unsigned*)(p.ws + WS_BAR);
        unsigned pre = 0;
        for (unsigned j = 0; j < 16; ++j) { const unsigned c = xb_ld(&bw[XB_XCNT(j)]); pre += (j < bar.x) ? c : 0u; }
        const unsigned lin = pre + bar.st[2];
        vcu = (gridDim.x == 256 && lin < 256u) ? (int)((lin & 31u) * 8u + (lin >> 5)) : (int)blockIdx.x;
        vcu = __builtin_amdgcn_readfirstlane(vcu);
    }
    for (int r = 0; r < REPS(2); ++r) { EpiBf16 e{(bf16_t*)(p.ws + WS_Z), INC, 2}; gemm_phase(lds, (const bf16_t*)(p.ws + WS_H), (const bf16_t*)(p.ws + WS_WIN), MTOK, INC, DM, vcu, e); GRID_SYNC(); }
    for (int r = 0; r < REPS(3); ++r) { phase3(p, lds); GRID_SYNC(); }
    phase4(p, lds);
    GRID_SYNC();
    {
        const float* mod = (const float*)(p.ws + WS_MOD); float* xb = (float*)(p.ws + WS_XBUF); unsigned* cn = (unsigned*)(p.ws + WS_CNT);
        EpiMixOut e{p.in[0], (bf16_t*)(p.ws + WS_Y), (bf16_t*)(p.ws + WS_H), mod, p.in[5], p.in[21], RowX{xb, cn}, RowX{xb + (size_t)MTOK * 4, cn + 4096}};
        gemm_phase(lds, (const bf16_t*)(p.ws + WS_YCAT), (const bf16_t*)(p.ws + WS_WOUT), MTOK, DM, DM, vcu, e); GRID_SYNC();
    }
    for (int r = 0; r < REPS(7); ++r) { EpiUp e{(bf16_t*)(p.ws + WS_ACT), (float*)(p.ws + WS_HALO), p.in[24], p.in[25]}; gemm_phase(lds, (const bf16_t*)(p.ws + WS_H), (const bf16_t*)(p.ws + WS_WUP), MTOK, UPC, DM, vcu, e); GRID_SYNC(); }
    {
        const int nN = DM >> 8, nM = MTOK >> 8, nwg = nM * nN;
        for (int it = 0;; ++it) {
            const long L = (long)it * gridDim.x + vcu; if (L >= nwg) break;
            int wgid = (int)L; { const int qq = nwg / 8, rr = nwg % 8, xcd = wgid % 8, off = wgid / 8; wgid = (xcd < rr ? xcd * (qq + 1) : rr * (qq + 1) + (xcd - rr) * qq) + off; }
            const int nig = 8 * nN, gid = wgid / nig, fm = gid * 8, gsz = (nM - fm) < 8 ? (nM - fm) : 8;
            fixup_tile(p, fm + ((wgid % nig) % gsz));
        }
        EpiDownOut e{p.out, (const bf16_t*)(p.ws + WS_Y), (const float*)(p.ws + WS_MOD), p.in[22], RowX{(float*)(p.ws + WS_XBUF) + (size_t)MTOK * 8, (unsigned*)(p.ws + WS_CNT) + 8192}};
        gemm_phase(lds, (const bf16_t*)(p.ws + WS_ACT), (const bf16_t*)(p.ws + WS_WDOWN), MTOK, DM, DFF, vcu, e);
    }
}

extern "C" void kernel_launch(void* const* d_in, const int* in_sizes, int n_in, void* d_out, int out_size, void* d_ws, size_t ws_size, hipStream_t stream) {
    static int grid_blocks = 0;
    if (!grid_blocks) {
        int dev = 0, cus = 0, per_cu = 0;
        (void)hipGetDevice(&dev);
        (void)hipDeviceGetAttribute(&cus, hipDeviceAttributeMultiprocessorCount, dev);
        (void)hipFuncSetAttribute((const void*)fwd_megakernel, hipFuncAttributeMaxDynamicSharedMemorySize, LDS_BYTES);
        (void)hipOccupancyMaxActiveBlocksPerMultiprocessor(&per_cu, (const void*)fwd_megakernel, NTHR, LDS_BYTES);
        if (cus * per_cu < 256) fprintf(stderr, "resident capacity %d x %d < 256 blocks: the grid barrier cannot complete\n", cus, per_cu);
        grid_blocks = 256;
    }
    Params p{};
    for (int i = 0; i < 27; ++i) p.in[i] = (const float*)d_in[i];
    p.out = (float*)d_out; p.ws = (unsigned char*)d_ws;
    void* args[] = {&p};
    (void)hipMemsetAsync((unsigned char*)d_ws + WS_BAR, 0, WS_ZERO_BYTES, stream);
    hipError_t e = hipLaunchCooperativeKernel((const void*)fwd_megakernel, dim3(grid_blocks), dim3(NTHR), args, LDS_BYTES, stream);
    if (e != hipSuccess) fprintf(stderr, "cooperative launch failed: %s (grid %d)\n", hipGetErrorString(e), grid_blocks);
}
```
